# Optimizing an MI355X kernel written in HIP

```python
import math
import jax, jax.numpy as jnp
from jax import lax
import numpy as np

D_MODEL = 2048
BATCH = 4
SEQ = 4096
DEPTH = 1

RET_HEADS = 8
RET_QK_DIM = 128
RET_V_DIM = 256
RET_QK_WIDTH = RET_HEADS * RET_QK_DIM
RET_V_WIDTH = RET_HEADS * RET_V_DIM
RET_CHUNK = 128
ROPE_BASE = 10000.0
S5_GROUP = 16
S5_WIDTH = D_MODEL // 2
S5_GROUPS = S5_WIDTH // S5_GROUP
S5_STATE = 64
DT_MIN = 1e-3
DT_MAX = 1e-1
D_FF = -(-8 * D_MODEL // (3 * 256)) * 256
NORM_EPS = 1e-6
GN_EPS = 1e-5

IN_SIZES = (RET_QK_WIDTH, RET_QK_WIDTH, RET_V_WIDTH, RET_V_WIDTH, S5_WIDTH, D_MODEL, D_MODEL)
IN_WIDTH = sum(IN_SIZES)
IN_SPLITS = tuple(int(s) for s in np.cumsum(IN_SIZES)[:-1])

kernel_name = "hybrid_retention_s5_gated_block"


def rmsnorm(x, g):
    xf = x.astype(jnp.float32)
    y = xf * lax.rsqrt(jnp.mean(xf * xf, axis=-1, keepdims=True) + NORM_EPS)
    return (y * g.astype(jnp.float32)).astype(x.dtype)


def head_group_norm(y):
    yf = y.astype(jnp.float32)
    mu = jnp.mean(yf, axis=-1, keepdims=True)
    var = jnp.mean(jnp.square(yf - mu), axis=-1, keepdims=True)
    return ((yf - mu) * lax.rsqrt(var + GN_EPS)).astype(y.dtype)


def rope(t, cos, sin):
    t1, t2 = jnp.split(t, 2, axis=-1)
    return jnp.concatenate([t1 * cos - t2 * sin, t1 * sin + t2 * cos], axis=-1)


def retention(q, k, v):
    Bn, L, H, dk = q.shape
    dv = v.shape[-1]
    C = RET_CHUNK
    N = L // C
    dt = q.dtype
    log_g = jnp.log1p(-jnp.exp2(-5.0 - jnp.arange(H, dtype=jnp.float32)))
    idx = jnp.arange(C, dtype=jnp.float32)
    rel = idx[:, None] - idx[None, :]
    decay = jnp.where(rel[None] >= 0,
                      jnp.exp(jnp.maximum(rel, 0.0)[None] * log_g[:, None, None]), 0.0)
    w_state = jnp.exp((C - 1.0 - idx)[:, None] * log_g[None, :])
    w_cross = jnp.exp((idx + 1.0)[:, None] * log_g[None, :])
    chunk_decay = jnp.exp(C * log_g)

    qc = q.reshape(Bn, N, C, H, dk)
    kc = k.reshape(Bn, N, C, H, dk)
    vc = v.reshape(Bn, N, C, H, dv)

    scores = jnp.einsum('bnchd,bnshd->bnhcs', qc, kc) * decay.astype(dt)[None, None]
    inner = jnp.einsum('bnhcs,bnshv->bnchv', scores, vc)

    kv = jnp.einsum('bnchd,ch,bnchv->bnhdv', kc, w_state.astype(dt), vc)
    cd = chunk_decay.astype(dt)[None, :, None, None]

    def step(R, kv_n):
        return cd * R + kv_n, R

    R0 = jnp.zeros((Bn, H, dk, dv), dtype=kv.dtype)
    _, R_prev = lax.scan(step, R0, jnp.moveaxis(kv, 1, 0))
    R_prev = jnp.moveaxis(R_prev, 0, 1)

    cross = jnp.einsum('bnchd,bnhdv->bnchv', qc, R_prev) * w_cross.astype(dt)[None, None, :, :, None]
    return (inner + cross).reshape(Bn, L, H, dv)


def s5_ssm(u, a_re, a_im, log_dt, b_re, b_im, c_re, c_im, d_skip):
    Bn, L, _ = u.shape
    ug = u.reshape(Bn, L, S5_GROUPS, S5_GROUP)
    dt = jnp.exp(log_dt)[:, None]
    mag = jnp.exp(a_re * dt)
    lb_re = mag * jnp.cos(a_im * dt)
    lb_im = mag * jnp.sin(a_im * dt)
    nr = lb_re - 1.0
    den = a_re * a_re + a_im * a_im
    f_re = (nr * a_re + lb_im * a_im) / den
    f_im = (lb_im * a_re - nr * a_im) / den
    bb_re = f_re[..., None] * b_re - f_im[..., None] * b_im
    bb_im = f_re[..., None] * b_im + f_im[..., None] * b_re
    bu_re = jnp.einsum('blgh,gph->blgp', ug, bb_re)
    bu_im = jnp.einsum('blgh,gph->blgp', ug, bb_im)
    A_re = jnp.broadcast_to(lb_re, (L,) + lb_re.shape)
    A_im = jnp.broadcast_to(lb_im, (L,) + lb_im.shape)

    def combine(e1, e2):
        a1r, a1i, b1r, b1i = e1
        a2r, a2i, b2r, b2i = e2
        return (a1r * a2r - a1i * a2i,
                a1r * a2i + a1i * a2r,
                a2r * b1r - a2i * b1i + b2r,
                a2r * b1i + a2i * b1r + b2i)

    def scan_one(br, bi):
        _, _, xr, xi = lax.associative_scan(combine, (A_re, A_im, br, bi), axis=0)
        return xr, xi

    x_re, x_im = jax.vmap(scan_one)(bu_re, bu_im)
    y = (jnp.einsum('blgp,ghp->blgh', x_re, c_re)
         - jnp.einsum('blgp,ghp->blgh', x_im, c_im)
         + d_skip[None, None] * ug)
    return y.reshape(Bn, L, S5_WIDTH)


def token_mixer(h, w_in, w_ret_out, a_re, a_im, log_dt, b_re, b_im, c_re, c_im, d_skip,
                w_s5_glu, w_out, cos, sin):
    Bn, L, _ = h.shape
    proj = h @ w_in
    q, k, v, g_ret, u, gate_r, gate_s = jnp.split(proj, IN_SPLITS, axis=-1)
    q = rope(q.reshape(Bn, L, RET_HEADS, RET_QK_DIM), cos, sin)
    k = rope(k.reshape(Bn, L, RET_HEADS, RET_QK_DIM), cos, sin) * (RET_QK_DIM ** -0.5)
    v = v.reshape(Bn, L, RET_HEADS, RET_V_DIM)
    ret = head_group_norm(retention(q, k, v)).reshape(Bn, L, RET_V_WIDTH)
    y_ret = (jax.nn.silu(g_ret) * ret) @ w_ret_out
    y_ssm = jax.nn.gelu(s5_ssm(u, a_re, a_im, log_dt, b_re, b_im, c_re, c_im, d_skip))
    glu_a, glu_b = jnp.split(y_ssm @ w_s5_glu, 2, axis=-1)
    y_s5 = glu_a * jax.nn.sigmoid(glu_b)
    merged = jax.nn.sigmoid(gate_r) * y_ret + jax.nn.sigmoid(gate_s) * y_s5
    return merged @ w_out


def swiglu_ffn(h, w_ffn_in, w_ffn_out):
    a, b = jnp.split(h @ w_ffn_in, 2, axis=-1)
    return (jax.nn.silu(a) * b) @ w_ffn_out


def setup_inputs(seed: int = 0) -> dict:
    key = jax.random.key(seed)
    ks = jax.random.split(key, 20)
    f32 = jnp.float32

    def dense(k, shape, fan_in):
        return jax.random.normal(k, shape, f32) * (fan_in ** -0.5)

    x = jax.random.normal(ks[0], (BATCH, SEQ, D_MODEL), f32)
    c = jax.random.normal(ks[1], (BATCH, D_MODEL), f32)
    w_ada = dense(ks[2], (DEPTH, D_MODEL, 6 * D_MODEL), D_MODEL)
    b_ada = 0.01 * jax.random.normal(ks[3], (DEPTH, 6 * D_MODEL), f32)
    norm_gains = 1.0 + 0.05 * jax.random.normal(ks[4], (DEPTH, 4, D_MODEL), f32)
    w_in = dense(ks[5], (DEPTH, D_MODEL, IN_WIDTH), D_MODEL)
    w_ret_out = dense(ks[6], (DEPTH, RET_V_WIDTH, D_MODEL), RET_V_WIDTH)
    ssm_a_re = -0.5 + 0.01 * jax.random.normal(ks[7], (DEPTH, S5_GROUPS, S5_STATE), f32)
    ssm_a_im = jnp.broadcast_to(math.pi * jnp.arange(S5_STATE, dtype=f32),
                                (DEPTH, S5_GROUPS, S5_STATE))
    ssm_log_dt = jax.random.uniform(ks[8], (DEPTH, S5_GROUPS), f32,
                                    math.log(DT_MIN), math.log(DT_MAX))
    ssm_b_re = dense(ks[9], (DEPTH, S5_GROUPS, S5_STATE, S5_GROUP), 2 * S5_GROUP)
    ssm_b_im = dense(ks[10], (DEPTH, S5_GROUPS, S5_STATE, S5_GROUP), 2 * S5_GROUP)
    ssm_c_re = 0.5 * jax.random.normal(ks[11], (DEPTH, S5_GROUPS, S5_GROUP, S5_STATE), f32)
    ssm_c_im = 0.5 * jax.random.normal(ks[12], (DEPTH, S5_GROUPS, S5_GROUP, S5_STATE), f32)
    ssm_d = jax.random.normal(ks[13], (DEPTH, S5_GROUPS, S5_GROUP), f32)
    w_s5_glu = dense(ks[14], (DEPTH, S5_WIDTH, 2 * D_MODEL), S5_WIDTH)
    w_out = dense(ks[15], (DEPTH, D_MODEL, D_MODEL), D_MODEL)
    w_ffn_in = dense(ks[16], (DEPTH, D_MODEL, 2 * D_FF), D_MODEL)
    w_ffn_out = dense(ks[17], (DEPTH, D_FF, D_MODEL), D_FF)
    return {"x": x, "c": c, "w_ada": w_ada, "b_ada": b_ada, "norm_gains": norm_gains,
            "w_in": w_in, "w_ret_out": w_ret_out, "ssm_a_re": ssm_a_re, "ssm_a_im": ssm_a_im,
            "ssm_log_dt": ssm_log_dt, "ssm_b_re": ssm_b_re, "ssm_b_im": ssm_b_im,
            "ssm_c_re": ssm_c_re, "ssm_c_im": ssm_c_im, "ssm_d": ssm_d, "w_s5_glu": w_s5_glu,
            "w_out": w_out, "w_ffn_in": w_ffn_in, "w_ffn_out": w_ffn_out}


def reference(x, c, w_ada, b_ada, norm_gains, w_in, w_ret_out, ssm_a_re, ssm_a_im, ssm_log_dt,
              ssm_b_re, ssm_b_im, ssm_c_re, ssm_c_im, ssm_d, w_s5_glu, w_out, w_ffn_in, w_ffn_out):
    L = x.shape[1]
    pos = jnp.arange(L, dtype=jnp.float32)
    inv_freq = ROPE_BASE ** (-jnp.arange(RET_QK_DIM // 2, dtype=jnp.float32) * (2.0 / RET_QK_DIM))
    ang = pos[:, None] * inv_freq[None, :]
    cos = jnp.cos(ang)[None, :, None, :].astype(x.dtype)
    sin = jnp.sin(ang)[None, :, None, :].astype(x.dtype)
    c_act = jax.nn.silu(c)
    for l in range(DEPTH):
        mod = c_act @ w_ada[l] + b_ada[l]
        sh_m, sc_m, gt_m, sh_f, sc_f, gt_f = [m[:, None, :] for m in jnp.split(mod, 6, axis=-1)]
        g = norm_gains[l]
        h = rmsnorm(x, g[0]) * (1.0 + sc_m) + sh_m
        y = token_mixer(h, w_in[l], w_ret_out[l], ssm_a_re[l], ssm_a_im[l], ssm_log_dt[l],
                        ssm_b_re[l], ssm_b_im[l], ssm_c_re[l], ssm_c_im[l], ssm_d[l],
                        w_s5_glu[l], w_out[l], cos, sin)
        x = x + gt_m * rmsnorm(y, g[1])
        h = rmsnorm(x, g[2]) * (1.0 + sc_f) + sh_f
        y = swiglu_ffn(h, w_ffn_in[l], w_ffn_out[l])
        x = x + gt_f * rmsnorm(y, g[3])
    return x
```

```cpp
#include <hip/hip_runtime.h>
#include <hip/hip_cooperative_groups.h>
#include <cstdio>
#include <cstdint>
#include <cmath>
namespace cg = cooperative_groups;
#ifndef MK_PER_PHASE
#define MK_PER_PHASE 0
#endif
namespace pg8 {
#define PG8_LAS __attribute__((address_space(3)))
typedef unsigned short bf16_t;
typedef short bf16x8 __attribute__((ext_vector_type(8)));
typedef float f32x4 __attribute__((ext_vector_type(4)));
typedef unsigned u32x4 __attribute__((ext_vector_type(4)));
constexpr int BM = 256, BK = 64, HALF = 128, HTB = HALF * BK * 2  , STAGE_BYTES = 8 * HTB, NXCD = 8, WGM = 2;

__host__ __device__ __forceinline__ int lds_byte(int r, int c) { const int st = (r >> 4) * 2 + (c >> 5), rr = r & 15, cc = c & 31, ob = rr * 64 + cc * 2; return st * 1024 + (ob ^ (((ob >> 9) & 1) << 5)); }
__host__ __device__ __forceinline__ void stage_rc(int b, int& R, int& C) { const int st = b / 1024, sb = b % 1024, swz = sb ^ (((sb >> 9) & 1) << 5); R = (st >> 1) * 16 + swz / 64; C = (st & 1) * 32 + (swz % 64) / 2; }
__host__ __device__ __forceinline__ int perm32(int rho) { const int n = rho >> 4, i = rho & 15; return 8 * (i >> 2) + 4 * n + (i & 3); }

struct Unit { int pm, pn; };
struct Gemm { const bf16_t* A; const bf16_t* Bt; int M, N, K; };

struct StaticOrder {
    int nM, nN, nwg, G, c;
    __host__ __device__ void init(int M, int N, int G_, int c_) { nM = M / BM; nN = N / BM; nwg = nM * nN; G = G_; c = c_; }
    __host__ __device__ bool next(int i, Unit& u) const {
        const long L = (long)i * G + c; if (L >= nwg) return false;
        int wgid = (int)L; { const int q = nwg / NXCD, r = nwg % NXCD, xcd = wgid % NXCD, off = wgid / NXCD; wgid = (xcd < r ? xcd * (q + 1) : r * (q + 1) + (xcd - r) * q) + off; }
        const int nig = WGM * nN, gid = wgid / nig, fm = gid * WGM, gsz = (nM - fm) < WGM ? (nM - fm) : WGM;
        u.pm = fm + ((wgid % nig) % gsz); u.pn = (wgid % nig) / gsz; return true;
    }
    __device__ __forceinline__ void a_ready(const Unit&) const {}
    __device__ __forceinline__ void done(const Unit&) const {}
};

__device__ __forceinline__ unsigned cvt_pk_bf16(float lo, float hi) { unsigned r; asm volatile("v_cvt_pk_bf16_f32 %0, %1, %2" : "=v"(r) : "v"(lo), "v"(hi)); return r; }
typedef unsigned u32x2 __attribute__((ext_vector_type(2)));
__device__ __forceinline__ float bf_lo(unsigned w) { return __uint_as_float(w << 16); }
__device__ __forceinline__ float bf_hi(unsigned w) { return __uint_as_float(w & 0xffff0000u); }
__device__ __forceinline__ float fast_sigmoid(float x) { return __builtin_amdgcn_rcpf(1.0f + __expf(-x)); }
__device__ __forceinline__ float fast_silu(float x) { return x * fast_sigmoid(x); }
__device__ __forceinline__ float lg2_gamma(int h) {
    return h == 0 ? -0.04580368961312479f : h == 1 ? -0.02272007650008353f : h == 2 ? -0.011315313227834146f : h == 3 ? -0.005646563141142062f :
           h == 4 ? -0.002820519062378663f : h == 5 ? -0.0014095702546713536f : h == 6 ? -0.0007046129765893728f : -0.00035226347162902144f;
}
constexpr int PJ_INW = 10240, PJ_G = 4096, PJ_GR = 6144, PJ_GS = 8192, PJ_MTOK = 16384;

struct EpiProj {
    static constexpr bool PERM = true, AFTER_DRAIN = false;
    bf16_t* O; const float* rope; bf16_t* US;
    __device__ __forceinline__ void operator()(const f32x4 (&acc)[2][2][4][2], const Unit& u, int wr, int wc, int fr, int fq) const {
        const int pn = u.pn, row0 = u.pm * BM + wr * 64 + fr, colb = pn * BM + wc * 32 + 8 * fq;
        if (pn < 8) {
            const bool isk = pn >= 4; const int f0 = 4 * (4 * wc + fq);
#pragma unroll
            for (int ai = 0; ai < 2; ++ai)
#pragma unroll
                for (int m = 0; m < 4; ++m) {
                    const int row = row0 + ai * HALF + m * 16, pos = row & 4095; const float cpos = (float)(pos & 127);
                    const f32x4 cs = *(const f32x4*)(rope + pos * 64 + f0), sn = *(const f32x4*)(rope + 262144 + pos * 64 + f0);
#pragma unroll
                    for (int bj = 0; bj < 2; ++bj) {
                        const float l2 = lg2_gamma((pn & 3) * 2 + bj);
                        const float sc = isk ? __builtin_amdgcn_exp2f(-cpos * l2) * 0.08838834764831845f : __builtin_amdgcn_exp2f(cpos * l2);
                        const f32x4 v0 = acc[ai][bj][m][0], v1 = acc[ai][bj][m][1];
                        const f32x4 o1 = (v0 * cs - v1 * sn) * sc, o2 = (v0 * sn + v1 * cs) * sc;
                        u32x4 w; w.x = cvt_pk_bf16(o1[0], o1[1]); w.y = cvt_pk_bf16(o1[2], o1[3]); w.z = cvt_pk_bf16(o2[0], o2[1]); w.w = cvt_pk_bf16(o2[2], o2[3]);
                        *(u32x4*)(O + (size_t)row * PJ_INW + colb + bj * HALF) = w;
                    }
                }
        } else {
            const int mode = (pn >= 16 && pn < 24) ? 1 : (pn >= 28 ? 2 : 0);
            const bool isu = pn >= 24 && pn < 28;
            const int ocol = (pn >= 28 ? (pn - 4) : pn) * BM + wc * 32 + 8 * fq, ucol = (pn - 24) * BM + wc * 32 + 8 * fq;
#pragma unroll
            for (int ai = 0; ai < 2; ++ai)
#pragma unroll
                for (int m = 0; m < 4; ++m) {
                    const int row = row0 + ai * HALF + m * 16;
#pragma unroll
                    for (int bj = 0; bj < 2; ++bj) {
                        f32x4 v0 = acc[ai][bj][m][0], v1 = acc[ai][bj][m][1];
                        if (mode == 1) {
#pragma unroll
                            for (int i = 0; i < 4; ++i) { v0[i] = fast_silu(v0[i]); v1[i] = fast_silu(v1[i]); }
                        } else if (mode == 2) {
#pragma unroll
                            for (int i = 0; i < 4; ++i) { v0[i] = fast_sigmoid(v0[i]); v1[i] = fast_sigmoid(v1[i]); }
                        }
                        u32x4 w; w.x = cvt_pk_bf16(v0[0], v0[1]); w.y = cvt_pk_bf16(v0[2], v0[3]); w.z = cvt_pk_bf16(v1[0], v1[1]); w.w = cvt_pk_bf16(v1[2], v1[3]);
                        if (isu) { const int cu = ucol + bj * HALF; *(u32x4*)(US + ((size_t)(cu >> 4) * PJ_MTOK + row) * 16 + (cu & 8)) = w; }
                        else *(u32x4*)(O + (size_t)row * PJ_INW + ocol + bj * HALF) = w;
                    }
                }
        }
    }
};
struct EpiPlain {
    static constexpr bool PERM = true, AFTER_DRAIN = false;
    bf16_t* O; int ldc;
    __device__ __forceinline__ void operator()(const f32x4 (&acc)[2][2][4][2], const Unit& u, int wr, int wc, int fr, int fq) const {
        const int row0 = u.pm * BM + wr * 64 + fr, colb = u.pn * BM + wc * 32 + 8 * fq;
#pragma unroll
        for (int ai = 0; ai < 2; ++ai)
#pragma unroll
            for (int m = 0; m < 4; ++m) {
                const int row = row0 + ai * HALF + m * 16;
#pragma unroll
                for (int bj = 0; bj < 2; ++bj) {
                    const f32x4 v0 = acc[ai][bj][m][0], v1 = acc[ai][bj][m][1];
                    u32x4 w; w.x = cvt_pk_bf16(v0[0], v0[1]); w.y = cvt_pk_bf16(v0[2], v0[3]); w.z = cvt_pk_bf16(v1[0], v1[1]); w.w = cvt_pk_bf16(v1[2], v1[3]);
                    *(u32x4*)(O + (size_t)row * ldc + colb + bj * HALF) = w;
                }
            }
    }
};
template <bool GATED> struct EpiPair {
    static constexpr bool PERM = true, AFTER_DRAIN = false;
    bf16_t* O; int ldc; const bf16_t* gate; int gate_off;
    __device__ __forceinline__ void operator()(const f32x4 (&acc)[2][2][4][2], const Unit& u, int wr, int wc, int fr, int fq) const {
        const int row0 = u.pm * BM + wr * 64 + fr, o = u.pn * HALF + wc * 32 + 8 * fq;
#pragma unroll
        for (int ai = 0; ai < 2; ++ai)
#pragma unroll
            for (int m = 0; m < 4; ++m) {
                const int row = row0 + ai * HALF + m * 16;
                const f32x4 a0 = acc[ai][0][m][0], a1 = acc[ai][0][m][1], b0 = acc[ai][1][m][0], b1 = acc[ai][1][m][1];
                f32x4 r0, r1;
                if (GATED) {
                    const u32x4 g = __builtin_nontemporal_load((const u32x4*)(gate + (size_t)row * PJ_INW + gate_off + o));
                    r0[0] = a0[0] * fast_sigmoid(b0[0]) * bf_lo(g.x); r0[1] = a0[1] * fast_sigmoid(b0[1]) * bf_hi(g.x);
                    r0[2] = a0[2] * fast_sigmoid(b0[2]) * bf_lo(g.y); r0[3] = a0[3] * fast_sigmoid(b0[3]) * bf_hi(g.y);
                    r1[0] = a1[0] * fast_sigmoid(b1[0]) * bf_lo(g.z); r1[1] = a1[1] * fast_sigmoid(b1[1]) * bf_hi(g.z);
                    r1[2] = a1[2] * fast_sigmoid(b1[2]) * bf_lo(g.w); r1[3] = a1[3] * fast_sigmoid(b1[3]) * bf_hi(g.w);
                } else {
#pragma unroll
                    for (int i = 0; i < 4; ++i) { r0[i] = fast_silu(a0[i]) * b0[i]; r1[i] = fast_silu(a1[i]) * b1[i]; }
                }
                u32x4 w; w.x = cvt_pk_bf16(r0[0], r0[1]); w.y = cvt_pk_bf16(r0[2], r0[3]); w.z = cvt_pk_bf16(r1[0], r1[1]); w.w = cvt_pk_bf16(r1[2], r1[3]);
                *(u32x4*)(O + (size_t)row * ldc + o) = w;
            }
    }
};
struct EpiMerge {
    static constexpr bool PERM = true, AFTER_DRAIN = false;
    bf16_t* O; const bf16_t* proj; const bf16_t* ms;
    __device__ __forceinline__ void operator()(const f32x4 (&acc)[2][2][4][2], const Unit& u, int wr, int wc, int fr, int fq) const {
        const int row0 = u.pm * BM + wr * 64 + fr, colb = u.pn * BM + wc * 32 + 8 * fq;
#pragma unroll
        for (int ai = 0; ai < 2; ++ai)
#pragma unroll
            for (int m = 0; m < 4; ++m) {
                const int row = row0 + ai * HALF + m * 16;
#pragma unroll
                for (int bj = 0; bj < 2; ++bj) {
                    const int col = colb + bj * HALF;
                    const u32x4 g = __builtin_nontemporal_load((const u32x4*)(proj + (size_t)row * PJ_INW + PJ_GR + col)), s = __builtin_nontemporal_load((const u32x4*)(ms + (size_t)row * 2048 + col));
                    const f32x4 v0 = acc[ai][bj][m][0], v1 = acc[ai][bj][m][1];
                    u32x4 w;
                    w.x = cvt_pk_bf16(v0[0] * bf_lo(g.x) + bf_lo(s.x), v0[1] * bf_hi(g.x) + bf_hi(s.x));
                    w.y = cvt_pk_bf16(v0[2] * bf_lo(g.y) + bf_lo(s.y), v0[3] * bf_hi(g.y) + bf_hi(s.y));
                    w.z = cvt_pk_bf16(v1[0] * bf_lo(g.z) + bf_lo(s.z), v1[1] * bf_hi(g.z) + bf_hi(s.z));
                    w.w = cvt_pk_bf16(v1[2] * bf_lo(g.w) + bf_lo(s.w), v1[3] * bf_hi(g.w) + bf_hi(s.w));
                    *(u32x4*)(O + (size_t)row * 2048 + col) = w;
                }
            }
    }
};
template <class Epi, class Sched, bool ALIGN_EPI = false, bool SP2 = false>
__device__ __forceinline__ void gemm_phase(PG8_LAS unsigned char* lds, const Gemm g, const Sched& S, const Epi& E) {
    const int tid = threadIdx.x, wid = __builtin_amdgcn_readfirstlane(tid >> 6), lane = tid & 63, wr = wid >> 2, wc = wid & 3, fr = lane & 15, fq = lane >> 4;
    const int K = g.K, nt = K / BK;
    unsigned voffA[2], voffB[2];
#pragma unroll
    for (int i = 0; i < 2; ++i) { int R, C; stage_rc(tid * 16 + i * 8192, R, C); const int Rb = Epi::PERM ? ((R & ~31) + perm32(R & 31)) : R;
        voffA[i] = (unsigned)(R * K + C) * 2u; voffB[i] = (unsigned)(Rb * K + C) * 2u; }
    const size_t kstep = (size_t)(BK * 2);
    const size_t hstep = (size_t)HALF * K * 2;
    const size_t tstep = 2 * hstep;
    const unsigned ldsw = (unsigned)wid * 1024u;
    const int aoff = lds_byte(wr * 64 + fr, fq * 8), boff = lds_byte(wc * 32 + fr, fq * 8);
#define PG8_SA(b, h) (((b) * 2 + (h)) * HTB)
#define PG8_SB(b, h) ((4 + (b) * 2 + (h)) * HTB)
#define PG8_STAGE(bufoff, gbase, voff) do { _Pragma("unroll") for (int _i = 0; _i < 2; ++_i) \
        __builtin_amdgcn_global_load_lds((const unsigned*)((const char*)(gbase) + (voff)[_i]), (PG8_LAS unsigned*)(lds + (bufoff) + ldsw + _i * 8192), 16, 0, 0); } while (0)
#define PG8_LDA(dst, b, h) do { _Pragma("unroll") for (int m = 0; m < 4; ++m) _Pragma("unroll") for (int k = 0; k < 2; ++k) dst[m][k] = *(const PG8_LAS bf16x8*)(lds + PG8_SA(b, h) + aoff + m * 2048 + k * 1024); } while (0)
#define PG8_LDB(dst, b, h) do { _Pragma("unroll") for (int n = 0; n < 2; ++n) _Pragma("unroll") for (int k = 0; k < 2; ++k) dst[n][k] = *(const PG8_LAS bf16x8*)(lds + PG8_SB(b, h) + boff + n * 2048 + k * 1024); } while (0)
#define PG8_MMA(ai, bj, At, Bt) do { __builtin_amdgcn_s_setprio(1); _Pragma("unroll") for (int m = 0; m < 4; ++m) _Pragma("unroll") for (int n = 0; n < 2; ++n) _Pragma("unroll") for (int k = 0; k < 2; ++k) \
        acc[ai][bj][m][n] = __builtin_amdgcn_mfma_f32_16x16x32_bf16(Bt[n][k], At[m][k], acc[ai][bj][m][n], 0, 0, 0); __builtin_amdgcn_s_setprio(0); } while (0)
#define PG8_WAIT_V(n) asm volatile("s_waitcnt vmcnt(" #n ")" ::: "memory")
#define PG8_WAIT_L(n) asm volatile("s_waitcnt lgkmcnt(" #n ")" ::: "memory")
#define PG8_BAR __builtin_amdgcn_s_barrier()
#define PG8_SCHED __builtin_amdgcn_sched_barrier(0)
    Unit cur, nxt; int ui = 0;
    if (!S.next(0, cur)) return;
    f32x4 acc[2][2][4][2];
#pragma unroll
    for (int a = 0; a < 2; ++a)
#pragma unroll
        for (int b = 0; b < 2; ++b)
#pragma unroll
            for (int m = 0; m < 4; ++m)
#pragma unroll
                for (int n = 0; n < 2; ++n) acc[a][b][m][n] = (f32x4){0.f, 0.f, 0.f, 0.f};
    bf16x8 At[4][2], B0[2][2], B1[2][2];
    const char* cA = (const char*)g.A + (size_t)cur.pm * tstep; const char* cB = (const char*)g.Bt + (size_t)cur.pn * tstep;
    S.a_ready(cur);
    if constexpr (SP2) {
        PG8_STAGE(PG8_SB(0, 0), cB, voffB); PG8_STAGE(PG8_SB(0, 1), cB + hstep, voffB); PG8_STAGE(PG8_SA(0, 0), cA, voffA); PG8_STAGE(PG8_SA(0, 1), cA + hstep, voffA);
        if (wr == 1) PG8_BAR;
        PG8_WAIT_V(2); PG8_BAR;
        PG8_STAGE(PG8_SB(1, 0), cB + kstep, voffB); PG8_STAGE(PG8_SA(1, 0), cA + kstep, voffA); PG8_STAGE(PG8_SB(1, 1), cB + hstep + kstep, voffB);
        PG8_WAIT_V(6); PG8_BAR;
    } else {
        PG8_STAGE(PG8_SB(0, 0), cB, voffB); PG8_STAGE(PG8_SA(0, 0), cA, voffA); PG8_STAGE(PG8_SB(0, 1), cB + hstep, voffB); PG8_STAGE(PG8_SA(0, 1), cA + hstep, voffA);
        if (wr == 1) PG8_BAR;
        PG8_WAIT_V(4); PG8_BAR;
        PG8_STAGE(PG8_SB(1, 0), cB + kstep, voffB); PG8_STAGE(PG8_SA(1, 0), cA + kstep, voffA); PG8_STAGE(PG8_SB(1, 1), cB + hstep + kstep, voffB);
        PG8_WAIT_V(6); PG8_BAR;
    }
    for (;;) {
        const bool has_next = S.next(ui + 1, nxt);
        const char* nA = has_next ? (const char*)g.A + (size_t)nxt.pm * tstep : cA; const char* nB = has_next ? (const char*)g.Bt + (size_t)nxt.pn * tstep : cB;
        for (int t = 0; t < nt; t += 2) {
            const bool last = (t == nt - 2);
            const char* a1 = cA + (size_t)(t + 1) * kstep;
            const char* a2 = last ? nA : cA + (size_t)(t + 2) * kstep; const char* b2 = last ? nB : cB + (size_t)(t + 2) * kstep;
            const char* a3 = a2 + kstep; const char* b3 = b2 + kstep;
            if (last && has_next) S.a_ready(nxt);
            if constexpr (SP2) {
            PG8_LDB(B0, 0, 0); PG8_LDB(B1, 0, 1); PG8_SCHED; PG8_LDA(At, 0, 0); PG8_STAGE(PG8_SA(1, 1), a1 + hstep, voffA);
            PG8_WAIT_V(8); PG8_WAIT_L(0); PG8_BAR; PG8_MMA(0, 0, At, B0); PG8_MMA(0, 1, At, B1); PG8_BAR; PG8_SCHED;
            PG8_LDA(At, 0, 1); PG8_STAGE(PG8_SB(0, 0), b2, voffB); PG8_STAGE(PG8_SB(0, 1), b2 + hstep, voffB); PG8_STAGE(PG8_SA(0, 0), a2, voffA);
            PG8_WAIT_V(8); PG8_WAIT_L(0); PG8_BAR; PG8_MMA(1, 0, At, B0); PG8_MMA(1, 1, At, B1); PG8_BAR; PG8_SCHED;
            PG8_LDB(B0, 1, 0); PG8_LDB(B1, 1, 1); PG8_SCHED; PG8_LDA(At, 1, 0); PG8_STAGE(PG8_SA(0, 1), a2 + hstep, voffA);
            PG8_WAIT_V(8); PG8_WAIT_L(0); PG8_BAR; PG8_MMA(0, 0, At, B0); PG8_MMA(0, 1, At, B1); PG8_BAR; PG8_SCHED;
            PG8_LDA(At, 1, 1); PG8_STAGE(PG8_SB(1, 0), b3, voffB); PG8_STAGE(PG8_SB(1, 1), b3 + hstep, voffB); PG8_STAGE(PG8_SA(1, 0), a3, voffA);
            PG8_WAIT_V(8); PG8_WAIT_L(0); PG8_BAR; PG8_MMA(1, 0, At, B0); PG8_MMA(1, 1, At, B1); PG8_BAR; PG8_SCHED;
            } else {
            PG8_LDB(B0, 0, 0); PG8_SCHED; PG8_LDA(At, 0, 0); PG8_STAGE(PG8_SA(1, 1), a1 + hstep, voffA);
            PG8_WAIT_L(8); PG8_BAR; PG8_WAIT_L(0); PG8_MMA(0, 0, At, B0); PG8_BAR; PG8_SCHED;
            PG8_LDB(B1, 0, 1); PG8_STAGE(PG8_SB(0, 0), b2, voffB);
            PG8_BAR; PG8_WAIT_L(0); PG8_MMA(0, 1, At, B1); PG8_BAR;
            PG8_LDA(At, 0, 1); PG8_STAGE(PG8_SA(0, 0), a2, voffA);
            PG8_BAR; PG8_WAIT_L(0); PG8_MMA(1, 0, At, B0); PG8_BAR; PG8_SCHED;
            PG8_STAGE(PG8_SB(0, 1), b2 + hstep, voffB);
            PG8_WAIT_V(6); PG8_BAR; PG8_MMA(1, 1, At, B1); PG8_BAR;
            PG8_LDB(B0, 1, 0); PG8_SCHED; PG8_LDA(At, 1, 0); PG8_STAGE(PG8_SA(0, 1), a2 + hstep, voffA);
            PG8_WAIT_L(8); PG8_BAR; PG8_WAIT_L(0); PG8_MMA(0, 0, At, B0); PG8_BAR; PG8_SCHED;
            PG8_LDB(B1, 1, 1); PG8_STAGE(PG8_SB(1, 0), b3, voffB);
            PG8_BAR; PG8_WAIT_L(0); PG8_MMA(0, 1, At, B1); PG8_BAR;
            PG8_LDA(At, 1, 1); PG8_STAGE(PG8_SA(1, 0), a3, voffA);
            PG8_BAR; PG8_WAIT_L(0); PG8_MMA(1, 0, At, B0); PG8_BAR; PG8_SCHED;
            PG8_STAGE(PG8_SB(1, 1), b3 + hstep, voffB);
            PG8_WAIT_V(6); PG8_BAR; PG8_MMA(1, 1, At, B1); PG8_BAR;
            }
        }
        if constexpr (ALIGN_EPI) { if (wr == 0) PG8_BAR; }
        if constexpr (!Epi::AFTER_DRAIN) { E(acc, cur, wr, wc, fr, fq); S.done(cur); }
        if (!has_next) break;
#pragma unroll
        for (int a = 0; a < 2; ++a)
#pragma unroll
            for (int b = 0; b < 2; ++b)
#pragma unroll
                for (int m = 0; m < 4; ++m)
#pragma unroll
                    for (int n = 0; n < 2; ++n) acc[a][b][m][n] = (f32x4){0.f, 0.f, 0.f, 0.f};
        cur = nxt; cA = nA; cB = nB; ++ui;
        if constexpr (ALIGN_EPI) { if (wr == 1) PG8_BAR; }
    }
    PG8_WAIT_V(0);
    if constexpr (!ALIGN_EPI) { if (wr == 0) PG8_BAR; }
    PG8_BAR;
    if constexpr (Epi::AFTER_DRAIN) { E.fused(acc, cur, wr, wc, fr, fq, lds, wid, lane); S.done(cur); }
#undef PG8_SA
#undef PG8_SB
#undef PG8_STAGE
#undef PG8_LDA
#undef PG8_LDB
#undef PG8_MMA
#undef PG8_WAIT_V
#undef PG8_WAIT_L
#undef PG8_BAR
#undef PG8_SCHED
}
}

#define LAS __attribute__((address_space(3)))
typedef unsigned short bf16;
typedef unsigned v4u __attribute__((ext_vector_type(4)));
typedef unsigned v2u __attribute__((ext_vector_type(2)));
typedef float f32x4 __attribute__((ext_vector_type(4)));
typedef float f32x2 __attribute__((ext_vector_type(2)));
typedef short bf16x8 __attribute__((ext_vector_type(8)));
typedef short s16x4 __attribute__((ext_vector_type(4)));
constexpr int NWAVES = 8, NTHR = 512;
constexpr int MTOK = 16384, DM = 2048, INW = 11264, DFF = 5632, SEQL = 4096;
constexpr int PJW = 10240;
constexpr int Q_OFF = 0, K_OFF = 1024, V_OFF = 2048, G_OFF = 4096, GR_OFF = 6144, GS_OFF = 8192;
constexpr size_t MiB = (size_t)1 << 20;
constexpr size_t WS_PROJ = 0;
constexpr size_t WS_US = 320 * MiB;
constexpr size_t WS_WIN = 352 * MiB;
constexpr size_t WS_YS = WS_WIN;
constexpr size_t WS_WRET = 396 * MiB, WS_WGLU = 404 * MiB, WS_WOUT = 412 * MiB;
constexpr size_t WS_TAIL = 420 * MiB;
constexpr size_t WS_E = WS_TAIL;
constexpr size_t WS_XS = WS_TAIL + 32 * MiB;
constexpr size_t WS_MERGED = WS_TAIL;
constexpr size_t WS_X1B = WS_TAIL;
constexpr size_t WS_MOD = WS_TAIL + 64 * MiB;
constexpr size_t MOD_BYTES = 4 * 12288 * 8;
constexpr size_t WS_MODF = WS_TAIL + 64 * MiB + 512 * 1024;
constexpr size_t WS_BAR = WS_TAIL + 64 * MiB + 768 * 1024;
constexpr size_t CTL_ZERO_BYTES = 1 * MiB;
constexpr int LDS_BAR_OFF = 147456 - 64;
constexpr size_t WS_ROPE = WS_TAIL + 65 * MiB;
constexpr size_t WS_S5C = WS_TAIL + 67 * MiB;
constexpr size_t S5C_GROUP = 147456, S5C_WY = 16384, S5C_WE = 81920;
constexpr size_t WS_LBT = WS_TAIL + 76 * MiB;
constexpr size_t WS_PART = WS_TAIL + 78 * MiB;
constexpr size_t WS_END = WS_TAIL + 87 * MiB;
constexpr size_t WS_Y1 = 0;
constexpr size_t WS_ACT = 0;
constexpr size_t WS_H2 = 176 * MiB;
constexpr size_t WS_Y2 = 176 * MiB;
constexpr size_t WS_WFIN = 240 * MiB;
constexpr size_t WS_WFOUT = 284 * MiB;
constexpr size_t DO_H = 0, DO_XT = 0, DO_A2 = 0, DO_TT = 64 * MiB, DO_MS = 64 * MiB;
constexpr int LDS_BYTES = 147456;
constexpr int N_PHASES = 13;

#define LDS_WAIT() asm volatile("s_waitcnt lgkmcnt(0)" ::: "memory")
__device__ __forceinline__ unsigned f2bf(float f) { unsigned u = __builtin_bit_cast(unsigned, f); return (u + 0x7fffu + ((u >> 16) & 1u)) >> 16; }
__device__ __forceinline__ unsigned pk2(float lo, float hi) { return f2bf(lo) | (f2bf(hi) << 16); }
__device__ __forceinline__ float bflo(unsigned w) { return __uint_as_float(w << 16); }
__device__ __forceinline__ float bfhi(unsigned w) { return __uint_as_float(w & 0xffff0000u); }
__device__ __forceinline__ float wave_sum(float v) {
#pragma unroll
    for (int o = 1; o < 64; o <<= 1) v += __shfl_xor(v, o);
    return v;
}
#define MFMA16(a, b, c) __builtin_amdgcn_mfma_f32_16x16x32_bf16((a), (b), (c), 0, 0, 0)
__device__ __forceinline__ bf16x8 tr_frag(LAS unsigned char* img, int pitch, int krow0, int col0, int lane_off) {
    LAS unsigned char* p = img + krow0 * pitch + col0 * 2 + lane_off;
    const s16x4 lo = __builtin_bit_cast(s16x4, __builtin_amdgcn_ds_read_tr16_b64_v4i16((LAS s16x4*)p));
    const s16x4 hi = __builtin_bit_cast(s16x4, __builtin_amdgcn_ds_read_tr16_b64_v4i16((LAS s16x4*)(p + 4 * pitch)));
    return __builtin_shufflevector(lo, hi, 0, 1, 2, 3, 4, 5, 6, 7);
}

struct Args { const float* in[19]; float* out; unsigned char* ws; int ph_lo, ph_hi; };

enum { PERM_NONE = 0, PERM_WIN = 1, PERM_PAIR = 2 };
__device__ __forceinline__ int dest_row(int mode, int n, int halfN) {
    if (mode == PERM_WIN) { if (n >= 2048) return n; const int d = n & 127, dd = d & 63; return (n & ~127) + 8 * (dd >> 2) + 4 * (d >> 6) + (dd & 3); }
    if (mode == PERM_PAIR) { const int nn = n >= halfN ? 1 : 0, o = n - nn * halfN; return 256 * (o >> 7) + 128 * nn + (o & 127); }
    return n;
}
__device__ __forceinline__ void transpose_item(const float* W, int K, int N, bf16* WT, int mode, int halfN, LAS float* scr, int item, int lane) {
    const int nblk = N / 32, kb = item / nblk, nb = item % nblk, k0 = 64 * kb, n0 = 32 * nb;
#pragma unroll
    for (int i = 0; i < 32; ++i) { const int kk = 2 * i + (lane >> 5); scr[kk * 33 + (lane & 31)] = __builtin_nontemporal_load(W + (size_t)(k0 + kk) * N + n0 + (lane & 31)); }
    LDS_WAIT(); asm volatile("" ::: "memory");
    const int c = lane & 7;
#pragma unroll
    for (int j = 0; j < 4; ++j) { const int n = (lane >> 3) + 8 * j; const LAS float* s = scr + (8 * c) * 33 + n;
        v4u o; o.x = pk2(s[0 * 33], s[1 * 33]); o.y = pk2(s[2 * 33], s[3 * 33]); o.z = pk2(s[4 * 33], s[5 * 33]); o.w = pk2(s[6 * 33], s[7 * 33]);
        *(v4u*)(WT + (size_t)dest_row(mode, n0 + n, halfN) * K + k0 + 8 * c) = o; }
    LDS_WAIT(); asm volatile("" ::: "memory");
}
__device__ __forceinline__ void sincos_rev(double rev, float& s, float& c) {
    const float f = (float)(rev - rint(rev));
    s = __builtin_amdgcn_sinf(f); c = __builtin_amdgcn_cosf(f);
}
constexpr double INV_2PI = 0.15915494309189533577;

__device__ __forceinline__ void p0_s5_consts(const Args& a, int g, int part, LAS unsigned char* lds, int tid) {
    const float* a_re = a.in[7]; const float* a_im = a.in[8]; const float* log_dt = a.in[9];
    const float* b_re = a.in[10]; const float* b_im = a.in[11]; const float* c_re = a.in[12]; const float* c_im = a.in[13]; const float* dsk = a.in[14];
    LAS f32x2* PW = (LAS f32x2*)lds;
    LAS f32x2* BB = PW + 17 * 64;
    LAS f32x2* CC = BB + 64 * 16;
    LAS float* DD = (LAS float*)(CC + 1024);
    const int p0 = tid & 63, pb0 = tid >> 4, pb1 = pb0 + 32, hh = tid & 15;
    const float ldt = log_dt[g];
    const float are0 = a_re[g * 64 + p0], aim0 = a_im[g * 64 + p0];
    const float areb[2] = {a_re[g * 64 + pb0], a_re[g * 64 + pb1]}, aimb[2] = {a_im[g * 64 + pb0], a_im[g * 64 + pb1]};
    const float brv[2] = {b_re[(g * 64 + pb0) * 16 + hh], b_re[(g * 64 + pb1) * 16 + hh]}, biv[2] = {b_im[(g * 64 + pb0) * 16 + hh], b_im[(g * 64 + pb1) * 16 + hh]};
    const float crv[2] = {c_re[g * 1024 + tid], c_re[g * 1024 + tid + 512]}, civ[2] = {c_im[g * 1024 + tid], c_im[g * 1024 + tid + 512]};
    const float ddv = tid < 16 ? dsk[g * 16 + tid] : 0.f;
    const float dt = expf(ldt);
#pragma unroll
    for (int k = 0; k < 3; ++k) { const int tau = (tid >> 6) + 8 * k;
        if (tau < 17) { const float th = aim0 * dt, mg = expf((float)tau * (are0 * dt)); float sn, cs; sincos_rev((double)th * (double)tau * INV_2PI, sn, cs);
            PW[tau * 64 + p0] = (f32x2){mg * cs, mg * sn}; } }
#pragma unroll
    for (int k = 0; k < 2; ++k) { const float are = areb[k], aim = aimb[k];
        const float th = aim * dt, mg = expf(are * dt); float sn, cs; sincos_rev((double)th * INV_2PI, sn, cs);
        const float lre = mg * cs, lim = mg * sn, nr = lre - 1.0f, den = are * are + aim * aim;
        const float fre = (nr * are + lim * aim) / den, fim = (lim * are - nr * aim) / den;
        BB[tid + 512 * k] = (f32x2){fre * brv[k] - fim * biv[k], fre * biv[k] + fim * brv[k]};
        CC[tid + 512 * k] = (f32x2){crv[k], civ[k]}; }
    if (tid < 16) DD[tid] = ddv;
    __syncthreads();
    unsigned char* gc = a.ws + WS_S5C + (size_t)g * S5C_GROUP;
    if (part == 0 && tid < 64) ((f32x2*)(a.ws + WS_LBT))[g * 64 + tid] = PW[16 * 64 + tid];
    if (part < 2) for (int pi = part * 512 + tid; pi < part * 512 + 512; pi += NTHR) { const int delta = pi >> 6, ln = pi & 63, fq = ln >> 4, h = ln & 15, lag = delta - (fq >> 1);
        float v[8];
#pragma unroll
        for (int j = 0; j < 8; ++j) v[j] = 0.f;
        if (lag >= 0) {
            for (int p = 0; p < 64; ++p) { const f32x2 cc = CC[h * 64 + p], pw = PW[lag * 64 + p]; const float zr = cc.x * pw.x - cc.y * pw.y, zi = cc.x * pw.y + cc.y * pw.x;
#pragma unroll
                for (int j = 0; j < 8; ++j) { const f32x2 bb = BB[p * 16 + 8 * (fq & 1) + j]; v[j] += zr * bb.x - zi * bb.y; } }
            if (lag == 0) {
#pragma unroll
                for (int j = 0; j < 8; ++j) if (8 * (fq & 1) + j == h) v[j] += DD[h];
            }
        }
        v4u o; o.x = pk2(v[0], v[1]); o.y = pk2(v[2], v[3]); o.z = pk2(v[4], v[5]); o.w = pk2(v[6], v[7]);
        *(v4u*)(gc + (size_t)pi * 16) = o; }
    if (part == 2) for (int e = tid; e < 4096; e += NTHR) { const int ln = e & 63, ks = (e >> 6) & 7, nt = e >> 9, fq = ln >> 4, fr = ln & 15;
        const int n = 16 * nt + fr, p = n >> 1, ri = n & 1, s = 2 * ks + (fq >> 1); const f32x2 pw = PW[(15 - s) * 64 + p];
        float v[8];
#pragma unroll
        for (int j = 0; j < 8; ++j) { const f32x2 bb = BB[p * 16 + 8 * (fq & 1) + j]; v[j] = ri ? (pw.x * bb.y + pw.y * bb.x) : (pw.x * bb.x - pw.y * bb.y); }
        v4u o; o.x = pk2(v[0], v[1]); o.y = pk2(v[2], v[3]); o.z = pk2(v[4], v[5]); o.w = pk2(v[6], v[7]);
        *(v4u*)(gc + S5C_WE + (size_t)e * 16) = o; }
    if (part == 3) for (int e = tid; e < 4096; e += NTHR) { const int ln = e & 63, ks = (e >> 6) & 3, tt = e >> 8, fq = ln >> 4, h = ln & 15;
        float v[8];
#pragma unroll
        for (int jj = 0; jj < 4; ++jj) { const int p = 16 * ks + 4 * fq + jj; const f32x2 cc = CC[h * 64 + p], pw = PW[(tt + 1) * 64 + p];
            v[2 * jj] = cc.x * pw.x - cc.y * pw.y; v[2 * jj + 1] = -(cc.x * pw.y + cc.y * pw.x); }
        v4u o; o.x = pk2(v[0], v[1]); o.y = pk2(v[2], v[3]); o.z = pk2(v[4], v[5]); o.w = pk2(v[6], v[7]);
        *(v4u*)(gc + S5C_WY + (size_t)e * 16) = o; }
    __syncthreads();
}

__device__ __forceinline__ void p0_prologue(const Args& a, LAS unsigned char* lds, int tid, int lane, int wave, int G) {
    const int bx = blockIdx.x;
    for (int task = bx; task < 256; task += G) p0_s5_consts(a, task >> 2, task & 3, lds, tid);
    { float* rp = (float*)(a.ws + WS_ROPE);
      for (int i = bx * NTHR + tid; i < 4096 * 64; i += G * NTHR) { const int pos = i >> 6, j = i & 63;
          const float invf = exp2f(-(float)j * (13.287712379549449f / 64.0f)); const float ang = (float)pos * invf;
          float s, c; sincos_rev((double)ang * INV_2PI, s, c); rp[i] = c; rp[262144 + i] = s; } }
    { const float* cvec = a.in[1]; const float* w_ada = a.in[2]; float* part = (float*)(a.ws + WS_PART); LAS float* sl = (LAS float*)lds;
      for (int it = bx; it < 6 * 42; it += G) { const int cb = it % 6, kg = it / 6, r0 = kg < 38 ? kg * 48 : 1824 + (kg - 38) * 56, nr = kg < 38 ? 48 : 56;
          __syncthreads();
          if (tid < 4 * 56) { const int b = tid / 56, rr = tid % 56; const float cv = rr < nr ? cvec[b * 2048 + r0 + rr] : 0.f; sl[b * 56 + rr] = cv / (1.0f + expf(-cv)); }
          __syncthreads();
          f32x4 acc[4];
#pragma unroll
          for (int b = 0; b < 4; ++b) acc[b] = (f32x4){0.f, 0.f, 0.f, 0.f};
          const int col = cb * 2048 + tid * 4;
          for (int k0 = 0; k0 < nr; k0 += 8) {
              f32x4 wv[8];
#pragma unroll
              for (int kk = 0; kk < 8; ++kk) wv[kk] = __builtin_nontemporal_load((const f32x4*)(w_ada + (size_t)(r0 + k0 + kk) * 12288 + col));
#pragma unroll
              for (int kk = 0; kk < 8; ++kk)
#pragma unroll
                  for (int b = 0; b < 4; ++b) acc[b] += wv[kk] * sl[b * 56 + k0 + kk]; }
#pragma unroll
          for (int b = 0; b < 4; ++b) *(f32x4*)(part + ((size_t)kg * 4 + b) * 12288 + col) = acc[b];
      }
      __syncthreads(); }
    { LAS float* scr = (LAS float*)(lds + wave * 16384);
      const int gw = bx * NWAVES + wave, NGW = G * NWAVES;
      constexpr int I_IN = (DM / 64) * (INW / 32), I_SQ = (DM / 64) * (DM / 32), I_GLU = (1024 / 64) * (4096 / 32);
      for (int it = gw; it < I_IN + 2 * I_SQ + I_GLU; it += NGW) { int r = it;
          if (r < I_IN) { transpose_item(a.in[5], DM, INW, (bf16*)(a.ws + WS_WIN), PERM_WIN, 0, scr, r, lane); continue; } r -= I_IN;
          if (r < I_SQ) { transpose_item(a.in[6], DM, DM, (bf16*)(a.ws + WS_WRET), PERM_NONE, 0, scr, r, lane); continue; } r -= I_SQ;
          if (r < I_SQ) { transpose_item(a.in[16], DM, DM, (bf16*)(a.ws + WS_WOUT), PERM_NONE, 0, scr, r, lane); continue; } r -= I_SQ;
          transpose_item(a.in[15], 1024, 4096, (bf16*)(a.ws + WS_WGLU), PERM_PAIR, 2048, scr, r, lane); } }
}

__device__ __forceinline__ void p0b_mod_reduce(const Args& a, int gtid, int nthr) {
    const float* part = (const float*)(a.ws + WS_PART); const float* b_ada = a.in[3]; float* mf = (float*)(a.ws + WS_MODF);
    for (int i = gtid; i < 4 * 12288 / 4; i += nthr) { const int b = i / 3072, j4 = (i % 3072) * 4;
        f32x4 acc = *(const f32x4*)(b_ada + j4);
#pragma unroll 14
        for (int kg = 0; kg < 42; ++kg) acc += *(const f32x4*)(part + ((size_t)kg * 4 + b) * 12288 + j4);
        *(f32x4*)(mf + b * 12288 + j4) = acc; }
}
__device__ __forceinline__ f32x4 modf4(const float* modf_, int b, int idx) { return *(const f32x4*)(modf_ + b * 12288 + idx); }
__device__ __forceinline__ void p1_prenorm(const Args& a, int lane, int gw, int NGW) {
    const float* x = a.in[0]; const float* g0 = a.in[4]; const float* mf = (const float*)(a.ws + WS_MODF);
    bf16* H = (bf16*)((unsigned char*)a.out + DO_H);
    for (int rb = gw; rb < MTOK / 8; rb += NGW) { const int row0 = rb * 8, b = row0 >> 12;
        f32x4 ca[8], cb[8];
#pragma unroll
        for (int j = 0; j < 8; ++j) { const int col = 4 * (lane + 64 * j); ca[j] = *(const f32x4*)(g0 + col) * (1.0f + modf4(mf, b, 2048 + col)); cb[j] = modf4(mf, b, col); if (j & 1) asm volatile("" ::: "memory"); }
        f32x4 v[8], nv[8];
        { const f32x4* xr = (const f32x4*)(x + (size_t)row0 * DM) + lane;
#pragma unroll
          for (int j = 0; j < 8; ++j) v[j] = __builtin_nontemporal_load(xr + 64 * j); }
#pragma unroll
        for (int r = 0; r < 8; ++r) { const int row = row0 + r;
            if (r < 7) { const f32x4* xr = (const f32x4*)(x + (size_t)(row + 1) * DM) + lane;
#pragma unroll
                for (int j = 0; j < 8; ++j) nv[j] = __builtin_nontemporal_load(xr + 64 * j); }
            float ss = 0.f;
#pragma unroll
            for (int j = 0; j < 8; ++j) ss += (v[j].x * v[j].x + v[j].y * v[j].y) + (v[j].z * v[j].z + v[j].w * v[j].w);
            const float rstd = rsqrtf(wave_sum(ss) * (1.0f / DM) + 1e-6f);
            v2u* o8 = (v2u*)(H + (size_t)row * DM) + lane;
#pragma unroll
            for (int j = 0; j < 8; ++j) { const f32x4 h = v[j] * rstd * ca[j] + cb[j]; v2u w; w.x = pk2(h.x, h.y); w.y = pk2(h.z, h.w); o8[64 * j] = w; }
#pragma unroll
            for (int j = 0; j < 8; ++j) v[j] = nv[j]; } }
}
__device__ __forceinline__ void p8_mid(const Args& a, int lane, int gw, int NGW) {
    const float* x = a.in[0]; const float* gains = a.in[4]; const float* mod = (const float*)(a.ws + WS_MOD); const float* b_ada = a.in[3];
    const bf16* Y1 = (const bf16*)(a.ws + WS_Y1); bf16* H2 = (bf16*)(a.ws + WS_H2); const float* mf = (const float*)(a.ws + WS_MODF);
    for (int rb = gw; rb < MTOK / 8; rb += NGW) { const int row0 = rb * 8, b = row0 >> 12;
        f32x4 c1[8], ca[8];
#pragma unroll
        for (int j = 0; j < 8; ++j) { const int col = 4 * (lane + 64 * j); c1[j] = *(const f32x4*)(gains + 2048 + col) * modf4(mf, b, 4096 + col);
            ca[j] = *(const f32x4*)(gains + 4096 + col) * (1.0f + modf4(mf, b, 8192 + col)); if (j & 1) asm volatile("" ::: "memory"); }
#pragma unroll 1
        for (int r = 0; r < 8; ++r) { const int row = row0 + r;
            const f32x4* xr = (const f32x4*)(x + (size_t)row * DM) + lane; const v2u* yr = (const v2u*)(Y1 + (size_t)row * DM) + lane;
            f32x4 v[8]; v2u yw[8]; float ssy = 0.f;
#pragma unroll
            for (int j = 0; j < 8; ++j) { v[j] = __builtin_nontemporal_load(xr + 64 * j); yw[j] = __builtin_nontemporal_load(yr + 64 * j); }
#pragma unroll
            for (int j = 0; j < 8; ++j) { const f32x4 y = (f32x4){bflo(yw[j].x), bfhi(yw[j].x), bflo(yw[j].y), bfhi(yw[j].y)}; ssy += (y.x * y.x + y.y * y.y) + (y.z * y.z + y.w * y.w); }
            const float rstdy = rsqrtf(wave_sum(ssy) * (1.0f / DM) + 1e-6f); float ss = 0.f;
            v2u* xo = (v2u*)((bf16*)(a.ws + WS_X1B) + (size_t)row * DM) + lane;
#pragma unroll
            for (int j = 0; j < 8; ++j) { const f32x4 y = (f32x4){bflo(yw[j].x), bfhi(yw[j].x), bflo(yw[j].y), bfhi(yw[j].y)};
                v[j] = v[j] + c1[j] * (y * rstdy); { v2u xw; xw.x = pk2(v[j].x, v[j].y); xw.y = pk2(v[j].z, v[j].w); xo[64 * j] = xw; } ss += (v[j].x * v[j].x + v[j].y * v[j].y) + (v[j].z * v[j].z + v[j].w * v[j].w); }
            f32x4 cbv[8];
#pragma unroll
            for (int j = 0; j < 8; ++j) cbv[j] = modf4(mf, b, 6144 + 4 * (lane + 64 * j));
            const float rstd = rsqrtf(wave_sum(ss) * (1.0f / DM) + 1e-6f);
            v2u* o8 = (v2u*)(H2 + (size_t)row * DM) + lane;
#pragma unroll
            for (int j = 0; j < 8; ++j) { const f32x4 h = v[j] * rstd * ca[j] + cbv[j]; v2u w; w.x = pk2(h.x, h.y); w.y = pk2(h.z, h.w); o8[64 * j] = w; } } }
}
__device__ __forceinline__ void p11_final(const Args& a, int lane, int gw, int NGW) {
    const float* gains = a.in[4]; const float* mod = (const float*)(a.ws + WS_MOD); const float* b_ada = a.in[3];
    const bf16* Y2 = (const bf16*)(a.ws + WS_Y2); const float* mf = (const float*)(a.ws + WS_MODF);
    for (int rb = gw; rb < MTOK / 8; rb += NGW) { const int row0 = rb * 8, b = row0 >> 12;
        f32x4 c3[8];
#pragma unroll
        for (int j = 0; j < 8; ++j) { const int col = 4 * (lane + 64 * j); c3[j] = *(const f32x4*)(gains + 6144 + col) * modf4(mf, b, 10240 + col); }
#pragma unroll 2
        for (int r = 0; r < 8; ++r) { const int row = row0 + r;
            f32x4* xr = (f32x4*)(a.out + (size_t)row * DM) + lane; const v2u* yr = (const v2u*)(Y2 + (size_t)row * DM) + lane;
            const v2u* x1r = (const v2u*)((const bf16*)(a.ws + WS_X1B) + (size_t)row * DM) + lane;
            f32x4 v[8]; v2u yw[8]; float ssy = 0.f;
#pragma unroll
            for (int j = 0; j < 8; ++j) { const v2u xw = __builtin_nontemporal_load(x1r + 64 * j); v[j] = (f32x4){bflo(xw.x), bfhi(xw.x), bflo(xw.y), bfhi(xw.y)}; yw[j] = __builtin_nontemporal_load(yr + 64 * j); }
#pragma unroll
            for (int j = 0; j < 8; ++j) { const f32x4 y = (f32x4){bflo(yw[j].x), bfhi(yw[j].x), bflo(yw[j].y), bfhi(yw[j].y)}; ssy += (y.x * y.x + y.y * y.y) + (y.z * y.z + y.w * y.w); }
            const float rstdy = rsqrtf(wave_sum(ssy) * (1.0f / DM) + 1e-6f);
#pragma unroll
            for (int j = 0; j < 8; ++j) { const f32x4 y = (f32x4){bflo(yw[j].x), bfhi(yw[j].x), bflo(yw[j].y), bfhi(yw[j].y)}; xr[64 * j] = v[j] + c3[j] * (y * rstdy); } } }
}

constexpr int RA_KP = 288, RA_VP = 544, RA_K = 0, RA_V = 128 * RA_KP;
constexpr int RC_P = 272, RC_VP = 288, RC_Q = 0, RC_K = 128 * RC_P, RC_V = 2 * 128 * RC_P, RC_T = RC_V + 128 * RC_VP;
__device__ __forceinline__ void retA_phase(const bf16* PROJ, bf16* XT, LAS unsigned char* lds, int tid, int lane, int w, int bx, int G) {
    const int fq = lane >> 4, fr = lane & 15;
    const int loK = (8 * fq + (fr >> 2)) * RA_KP + 8 * (lane & 3), loV = (8 * fq + (fr >> 2)) * RA_VP + 8 * (lane & 3);
    v4u rk[4], rv[8];
    v2u pend[16]; bf16* pxo = nullptr;
    int uid = bx;
    if (uid < 1024) { const int b = uid >> 8, h = (uid >> 5) & 7, n = uid & 31, tok0 = b * SEQL + n * 128;
#pragma unroll
        for (int i = 0; i < 4; ++i) { const int id = tid + NTHR * i; rk[i] = __builtin_nontemporal_load((const v4u*)(PROJ + (size_t)(tok0 + (id >> 4)) * PJW + K_OFF + h * 128 + (id & 15) * 8)); }
#pragma unroll
        for (int i = 0; i < 8; ++i) { const int id = tid + NTHR * i; rv[i] = __builtin_nontemporal_load((const v4u*)(PROJ + (size_t)(tok0 + (id >> 5)) * PJW + V_OFF + h * 256 + (id & 31) * 8)); } }
    for (; uid < 1024; uid += G) {
#pragma unroll
        for (int i = 0; i < 4; ++i) { const int id = tid + NTHR * i; *(LAS v4u*)(lds + RA_K + (id >> 4) * RA_KP + (id & 15) * 16) = rk[i]; }
#pragma unroll
        for (int i = 0; i < 8; ++i) { const int id = tid + NTHR * i; *(LAS v4u*)(lds + RA_V + (id >> 5) * RA_VP + (id & 31) * 16) = rv[i]; }
        __syncthreads();
        if (pxo) {
#pragma unroll
            for (int nt = 0; nt < 16; ++nt) *(v2u*)(pxo + (16 * nt + fr) * 128 + 16 * w + 4 * fq) = pend[nt]; }
        const int nuid = uid + G;
        if (nuid < 1024) { const int b = nuid >> 8, h = (nuid >> 5) & 7, n = nuid & 31, tok0 = b * SEQL + n * 128;
#pragma unroll
            for (int i = 0; i < 4; ++i) { const int id = tid + NTHR * i; rk[i] = __builtin_nontemporal_load((const v4u*)(PROJ + (size_t)(tok0 + (id >> 4)) * PJW + K_OFF + h * 128 + (id & 15) * 8)); }
#pragma unroll
            for (int i = 0; i < 8; ++i) { const int id = tid + NTHR * i; rv[i] = __builtin_nontemporal_load((const v4u*)(PROJ + (size_t)(tok0 + (id >> 5)) * PJW + V_OFF + h * 256 + (id & 31) * 8)); } }
        bf16x8 af[4];
#pragma unroll
        for (int ks = 0; ks < 4; ++ks) af[ks] = tr_frag(lds + RA_K, RA_KP, 32 * ks, 16 * w, loK);
        bf16* xo = XT + (size_t)uid * 32768;
#pragma unroll
        for (int nt = 0; nt < 16; ++nt) { f32x4 acc = (f32x4){0.f, 0.f, 0.f, 0.f}; bf16x8 bfr[4];
#pragma unroll
            for (int ks = 0; ks < 4; ++ks) bfr[ks] = tr_frag(lds + RA_V, RA_VP, 32 * ks, 16 * nt, loV);
            __builtin_amdgcn_sched_barrier(0);
#pragma unroll
            for (int ks = 0; ks < 4; ++ks) acc = MFMA16(af[ks], bfr[ks], acc);
            __builtin_amdgcn_sched_barrier(0);
            v2u o; o.x = pk2(acc[0], acc[1]); o.y = pk2(acc[2], acc[3]);
            pend[nt] = o; }
        pxo = xo;
        __syncthreads();
    }
    if (pxo) {
#pragma unroll
        for (int nt = 0; nt < 16; ++nt) *(v2u*)(pxo + (16 * nt + fr) * 128 + 16 * w + 4 * fq) = pend[nt]; }
}
__device__ __forceinline__ void retB_scan(const bf16* XT, bf16* TT, int first, int stride) {
    for (int e = first; e < 32 * 4096; e += stride) { const int bh = e >> 12, off = (e & 4095) * 8; const int h = bh & 7;
        const float cd = exp2f(128.0f * pg8::lg2_gamma(h));
        float t[8];
#pragma unroll
        for (int j = 0; j < 8; ++j) t[j] = 0.f;
        const bf16* xp = XT + (size_t)bh * 32 * 32768 + off; bf16* tp = TT + (size_t)bh * 32 * 32768 + off;
#pragma unroll 1
        for (int n0 = 0; n0 < 32; n0 += 16) {
        v4u xv[16];
#pragma unroll
        for (int n = 0; n < 16; ++n) xv[n] = __builtin_nontemporal_load((const v4u*)(xp + (size_t)(n0 + n) * 32768));
#pragma unroll
        for (int n = 0; n < 16; ++n) {
            v4u o; o.x = pk2(t[0], t[1]); o.y = pk2(t[2], t[3]); o.z = pk2(t[4], t[5]); o.w = pk2(t[6], t[7]);
            *(v4u*)(tp + (size_t)(n0 + n) * 32768) = o;
            t[0] = cd * t[0] + bflo(xv[n].x); t[1] = cd * t[1] + bfhi(xv[n].x); t[2] = cd * t[2] + bflo(xv[n].y); t[3] = cd * t[3] + bfhi(xv[n].y);
            t[4] = cd * t[4] + bflo(xv[n].z); t[5] = cd * t[5] + bfhi(xv[n].z); t[6] = cd * t[6] + bflo(xv[n].w); t[7] = cd * t[7] + bfhi(xv[n].w); } } }
}
__device__ __forceinline__ void retC_phase(const bf16* PROJ, const bf16* TT, bf16* A2, LAS unsigned char* lds, int tid, int lane, int w, int bx, int G) {
    const int fq = lane >> 4, fr = lane & 15, srow = tid >> 4, sch = tid & 15;
    const int loV = (8 * fq + (fr >> 2)) * RC_VP + 8 * (lane & 3);
    LAS unsigned char* si = lds + RC_K + w * (16 * RC_P);
    v4u rq[4], rk[4], rv[4], rt[4];
    v2u pend[16]; bf16* pop = nullptr;
    int uid = bx;
    if (uid < 1024) { const int b = uid >> 8, h = (uid >> 5) & 7, n = uid & 31, tok0 = b * SEQL + n * 128;
#pragma unroll
        for (int i = 0; i < 4; ++i) { const int row = srow + 32 * i; const bf16* pr = PROJ + (size_t)(tok0 + row) * PJW + sch * 8;
            rq[i] = __builtin_nontemporal_load((const v4u*)(pr + Q_OFF + h * 128)); rk[i] = __builtin_nontemporal_load((const v4u*)(pr + K_OFF + h * 128)); rv[i] = __builtin_nontemporal_load((const v4u*)(pr + V_OFF + h * 256));
            rt[i] = __builtin_nontemporal_load((const v4u*)(TT + (size_t)uid * 32768 + row * 128 + sch * 8)); } }
    for (; uid < 1024; uid += G) {
        const int b = uid >> 8, h = (uid >> 5) & 7, n = uid & 31, tok0 = b * SEQL + n * 128;
#pragma unroll
        for (int i = 0; i < 4; ++i) { const int row = srow + 32 * i;
            *(LAS v4u*)(lds + RC_Q + row * RC_P + sch * 16) = rq[i]; *(LAS v4u*)(lds + RC_K + row * RC_P + sch * 16) = rk[i];
            *(LAS v4u*)(lds + RC_V + row * RC_VP + sch * 16) = rv[i]; *(LAS v4u*)(lds + RC_T + row * RC_P + sch * 16) = rt[i]; }
        __syncthreads();
        if (pop) {
#pragma unroll
            for (int t = 0; t < 16; ++t) *(v2u*)(pop + 16 * t) = pend[t]; }
#pragma unroll
        for (int i = 0; i < 4; ++i) { const int row = srow + 32 * i;
            rv[i] = __builtin_nontemporal_load((const v4u*)(PROJ + (size_t)(tok0 + row) * PJW + V_OFF + h * 256 + 128 + sch * 8));
            rt[i] = __builtin_nontemporal_load((const v4u*)(TT + (size_t)uid * 32768 + (128 + row) * 128 + sch * 8)); }
        bf16x8 qf[4];
#pragma unroll
        for (int ks = 0; ks < 4; ++ks) qf[ks] = *(const LAS bf16x8*)(lds + RC_Q + (16 * w + fr) * RC_P + (32 * ks + 8 * fq) * 2);
        v2u sp[8];
#pragma unroll
        for (int st = 0; st < 8; ++st) { sp[st] = (v2u){0u, 0u};
            if (st <= w) { f32x4 sa = (f32x4){0.f, 0.f, 0.f, 0.f}; bf16x8 kfr[4];
#pragma unroll
                for (int ks = 0; ks < 4; ++ks) kfr[ks] = *(const LAS bf16x8*)(lds + RC_K + (16 * st + fr) * RC_P + (32 * ks + 8 * fq) * 2);
                __builtin_amdgcn_sched_barrier(0);
#pragma unroll
                for (int ks = 0; ks < 4; ++ks) sa = MFMA16(kfr[ks], qf[ks], sa);
                __builtin_amdgcn_sched_barrier(0);
                const int c = 16 * w + fr, s0 = 16 * st + 4 * fq;
#pragma unroll
                for (int i = 0; i < 4; ++i) if (s0 + i > c) sa[i] = 0.f;
                sp[st].x = pk2(sa[0], sa[1]); sp[st].y = pk2(sa[2], sa[3]); } }
        __syncthreads();
#pragma unroll
        for (int st = 0; st < 8; ++st) *(LAS v2u*)(si + fr * RC_P + (16 * st + 4 * fq) * 2) = sp[st];
        bf16x8 sf[4];
#pragma unroll
        for (int ks = 0; ks < 4; ++ks) sf[ks] = *(const LAS bf16x8*)(si + fr * RC_P + (32 * ks + 8 * fq) * 2);
        const float cd = exp2f(128.0f * pg8::lg2_gamma(h));
        f32x4 o[16];
#define RC_HALF(vh, SB) _Pragma("unroll") for (int vt = 0; vt < 8; ++vt) { f32x4 acc = (f32x4){0.f, 0.f, 0.f, 0.f}; bf16x8 tfr[4], vfr[4]; \
            _Pragma("unroll") for (int ks = 0; ks < 4; ++ks) { tfr[ks] = *(const LAS bf16x8*)(lds + RC_T + (16 * vt + fr) * RC_P + (32 * ks + 8 * fq) * 2); vfr[ks] = tr_frag(lds + RC_V, RC_VP, 32 * ks, 16 * vt, loV); } \
            if (SB) __builtin_amdgcn_sched_barrier(0); \
            f32x4 accv = (f32x4){0.f, 0.f, 0.f, 0.f}; \
            _Pragma("unroll") for (int ks = 0; ks < 4; ++ks) { acc = MFMA16(tfr[ks], qf[ks], acc); accv = MFMA16(vfr[ks], sf[ks], accv); } \
            acc = acc * cd + accv; \
            if (SB) __builtin_amdgcn_sched_barrier(0); \
            o[(vh) * 8 + vt] = acc; }
        RC_HALF(0, true)
        __syncthreads();
#pragma unroll
        for (int i = 0; i < 4; ++i) { const int row = srow + 32 * i;
            *(LAS v4u*)(lds + RC_V + row * RC_VP + sch * 16) = rv[i]; *(LAS v4u*)(lds + RC_T + row * RC_P + sch * 16) = rt[i]; }
        __syncthreads();
        const int nuid = uid + G;
        if (nuid < 1024) { const int b2 = nuid >> 8, h2 = (nuid >> 5) & 7, n2 = nuid & 31, tk2 = b2 * SEQL + n2 * 128;
#pragma unroll
            for (int i = 0; i < 4; ++i) { const int row = srow + 32 * i; const bf16* pr = PROJ + (size_t)(tk2 + row) * PJW + sch * 8;
                rq[i] = __builtin_nontemporal_load((const v4u*)(pr + Q_OFF + h2 * 128)); rk[i] = __builtin_nontemporal_load((const v4u*)(pr + K_OFF + h2 * 128)); rv[i] = __builtin_nontemporal_load((const v4u*)(pr + V_OFF + h2 * 256));
                rt[i] = __builtin_nontemporal_load((const v4u*)(TT + (size_t)nuid * 32768 + row * 128 + sch * 8)); } }
        const int tok = tok0 + 16 * w + fr;
        const bf16* gp = PROJ + (size_t)tok * PJW + G_OFF + h * 256 + 4 * fq; bf16* op = A2 + (size_t)tok * DM + h * 256 + 4 * fq;
        RC_HALF(1, true)
        v2u rg[16];
#pragma unroll
        for (int t = 0; t < 16; ++t) rg[t] = __builtin_nontemporal_load((const v2u*)(gp + 16 * t));
#undef RC_HALF
        float s1 = 0.f;
#pragma unroll
        for (int t = 0; t < 16; ++t) s1 += (o[t][0] + o[t][1]) + (o[t][2] + o[t][3]);
        s1 += __shfl_xor(s1, 16); s1 += __shfl_xor(s1, 32);
        const float mu = s1 * (1.0f / 256.0f); float s2 = 0.f;
#pragma unroll
        for (int t = 0; t < 16; ++t) { const f32x4 d = o[t] - mu; s2 += (d[0] * d[0] + d[1] * d[1]) + (d[2] * d[2] + d[3] * d[3]); }
        s2 += __shfl_xor(s2, 16); s2 += __shfl_xor(s2, 32);
        const float rstd = rsqrtf(s2 * (1.0f / 256.0f) + 1e-5f);
#pragma unroll
        for (int t = 0; t < 16; ++t) { const v2u g = rg[t]; const f32x4 d = (o[t] - mu) * rstd;
            v2u wv; wv.x = pk2(d[0] * bflo(g.x), d[1] * bfhi(g.x)); wv.y = pk2(d[2] * bflo(g.y), d[3] * bfhi(g.y)); pend[t] = wv; }
        pop = op;
        __syncthreads();
    }
    if (pop) {
#pragma unroll
        for (int t = 0; t < 16; ++t) *(v2u*)(pop + 16 * t) = pend[t]; }
}

__device__ __forceinline__ void s5_load_u(const bf16* US, int t, int g, int lane, bf16x8 (&uf)[8]) {
    const int fq = lane >> 4, fr = lane & 15;
    const bf16* up = US + ((size_t)g * MTOK + 256 * t + 16 * fr + (fq >> 1)) * 16 + 8 * (fq & 1);
#pragma unroll
    for (int ks = 0; ks < 8; ++ks) uf[ks] = __builtin_nontemporal_load((const bf16x8*)(up + 32 * ks));
}
__device__ __forceinline__ void s5_local_state(const Args& a, int t, int g, int lane, LAS unsigned char* we) {
    const bf16* PROJ = (const bf16*)(a.ws + WS_PROJ); float* E = (float*)(a.ws + WS_E);
    const int fq = lane >> 4, fr = lane & 15, b = t >> 4;
    bf16x8 uf[8]; s5_load_u((const bf16*)(a.ws + WS_US), t, g, lane, uf);
    float* ep = E + ((size_t)(b * 256 + (t & 15) * 16 + fr) * 64 + g) * 128 + 4 * fq;
#pragma unroll
    for (int nt = 0; nt < 8; ++nt) { f32x4 acc = (f32x4){0.f, 0.f, 0.f, 0.f}; bf16x8 wfr[8];
#pragma unroll
        for (int ks = 0; ks < 8; ++ks) wfr[ks] = *(const LAS bf16x8*)(we + ((nt * 8 + ks) * 64 + lane) * 16);
        __builtin_amdgcn_sched_barrier(0);
        f32x4 acc2 = (f32x4){0.f, 0.f, 0.f, 0.f};
#pragma unroll
        for (int ks = 0; ks < 8; ++ks) { if (ks & 1) acc2 = MFMA16(wfr[ks], uf[ks], acc2); else acc = MFMA16(wfr[ks], uf[ks], acc); }
        acc = acc + acc2;
        __builtin_amdgcn_sched_barrier(0);
        *(f32x4*)(ep + 16 * nt) = acc; }
}
__device__ __forceinline__ void s5_carry_scan(const Args& a, int pair, int lane, int w, LAS unsigned char* lds) {
    const int b = pair >> 6, g = pair & 63;
    const f32x2 lb = ((const f32x2*)(a.ws + WS_LBT))[g * 64 + lane];
    const float* ep = (const float*)(a.ws + WS_E) + ((size_t)(b * 256 + 32 * w) * 64 + g) * 128 + 2 * lane;
    bf16* xp = (bf16*)(a.ws + WS_XS) + ((size_t)(b * 256 + 32 * w) * 64 + g) * 128 + 2 * lane;
    LAS f32x2* seg = (LAS f32x2*)lds;
    f32x2 e[32];
#pragma unroll
    for (int i = 0; i < 32; ++i) e[i] = __builtin_nontemporal_load((const f32x2*)(ep + (size_t)i * 8192));
    float sr = 0.f, si = 0.f;
#pragma unroll
    for (int i = 0; i < 32; ++i) { const float nr = lb.x * sr - lb.y * si + e[i].x, ni = lb.x * si + lb.y * sr + e[i].y; sr = nr; si = ni; }
    __syncthreads();
    seg[w * 64 + lane] = (f32x2){sr, si};
    f32x2 l32 = lb;
#pragma unroll
    for (int q = 0; q < 5; ++q) l32 = (f32x2){l32.x * l32.x - l32.y * l32.y, 2.0f * l32.x * l32.y};
    __syncthreads();
    float xr = 0.f, xi = 0.f;
    for (int j = 0; j < w; ++j) { const f32x2 sj = seg[j * 64 + lane]; const float nr = l32.x * xr - l32.y * xi + sj.x, ni = l32.x * xi + l32.y * xr + sj.y; xr = nr; xi = ni; }
#pragma unroll
    for (int i = 0; i < 32; ++i) { *(unsigned*)(xp + (size_t)i * 8192) = pk2(xr, xi);
        const float nr = lb.x * xr - lb.y * xi + e[i].x, ni = lb.x * xi + lb.y * xr + e[i].y; xr = nr; xi = ni; }
}
__device__ __forceinline__ float gelu_tanh(float x) {
    const float z = 0.7978845608028654f * (x + 0.044715f * x * x * x);
    const float e = __expf(2.0f * z);
    return 0.5f * x * (2.0f - 2.0f * __builtin_amdgcn_rcpf(e + 1.0f));
}
__device__ __forceinline__ void s5_output(const Args& a, int t, int g, int lane, LAS unsigned char* gc) {
    const bf16* PROJ = (const bf16*)(a.ws + WS_PROJ); const bf16* XS = (const bf16*)(a.ws + WS_XS); bf16* YS = (bf16*)(a.ws + WS_YS);
    const int fq = lane >> 4, fr = lane & 15, b = t >> 4;
    bf16x8 uf[8]; s5_load_u((const bf16*)(a.ws + WS_US), t, g, lane, uf);
    bf16x8 xf[4];
    const bf16* xsp = XS + ((size_t)(b * 256 + (t & 15) * 16 + fr) * 64 + g) * 128 + 8 * fq;
#pragma unroll
    for (int ks = 0; ks < 4; ++ks) xf[ks] = __builtin_nontemporal_load((const bf16x8*)(xsp + 32 * ks));
    bf16* yp = YS + (size_t)(256 * t + 16 * fr) * 1024 + 16 * g + 4 * fq;
#pragma unroll
    for (int tt = 0; tt < 16; ++tt) { f32x4 acc = (f32x4){0.f, 0.f, 0.f, 0.f}; bf16x8 tfr[8], wfr[4];
#pragma unroll
        for (int ks = 0; ks <= tt / 2; ++ks) tfr[ks] = *(const LAS bf16x8*)(gc + ((tt - 2 * ks) * 64 + lane) * 16);
#pragma unroll
        for (int ks = 0; ks < 4; ++ks) wfr[ks] = *(const LAS bf16x8*)(gc + (int)S5C_WY + ((tt * 4 + ks) * 64 + lane) * 16);
        __builtin_amdgcn_sched_barrier(0);
        f32x4 acc2 = (f32x4){0.f, 0.f, 0.f, 0.f};
#pragma unroll
        for (int ks = 0; ks <= tt / 2; ++ks) { if (ks & 1) acc2 = MFMA16(tfr[ks], uf[ks], acc2); else acc = MFMA16(tfr[ks], uf[ks], acc); }
#pragma unroll
        for (int ks = 0; ks < 4; ++ks) { if (ks & 1) acc = MFMA16(wfr[ks], xf[ks], acc); else acc2 = MFMA16(wfr[ks], xf[ks], acc2); }
        acc = acc + acc2;
        __builtin_amdgcn_sched_barrier(0);
        v2u o; o.x = pk2(gelu_tanh(acc[0]), gelu_tanh(acc[1])); o.y = pk2(gelu_tanh(acc[2]), gelu_tanh(acc[3]));
        *(v2u*)(yp + (size_t)tt * 1024) = o; }
}

#define RLX_AGENT __ATOMIC_RELAXED, __HIP_MEMORY_SCOPE_AGENT
#define XB_TMO      128
#define XB_XCNT(j)  (256  + 64 * (j))
#define XB_XSUB(j)  (1280 + 64 * (j))
#define XB_XGEN(j)  (2304 + 64 * (j))
#define XB_TOP      3328
#define XB_TOPGEN   3392
#define XCD_BAR_WORDS 3456
#define XB_SPIN_CAP (1u << 18)

__device__ __forceinline__ unsigned xb_ld(unsigned* p)              { return __hip_atomic_load(p, __ATOMIC_RELAXED, __HIP_MEMORY_SCOPE_AGENT); }
__device__ __forceinline__ unsigned xb_add(unsigned* p, unsigned v) { return __hip_atomic_fetch_add(p, v, __ATOMIC_RELAXED, __HIP_MEMORY_SCOPE_AGENT); }
__device__ __forceinline__ unsigned xb_xcc_id() { return (unsigned)__builtin_amdgcn_s_getreg((3 << 11) | 20) & 0xFu; }
#define XB_SPIN(cond, bar) do { unsigned _sp = 0; while (cond) { __builtin_amdgcn_s_sleep(1); \
    if ((++_sp & 255u) == 0u) { if (xb_ld(&(bar)[XB_TMO])) break; if (_sp > XB_SPIN_CAP) { atomicAdd(&(bar)[XB_TMO], 1u); break; } } } } while (0)

struct XcdBarrier {
    unsigned* bar; unsigned x;
    volatile LAS unsigned* st;
};

__device__ __forceinline__ XcdBarrier xcd_barrier_post(unsigned* bar, volatile LAS unsigned* st) {
    XcdBarrier b; b.bar = bar; b.x = xb_xcc_id(); b.st = st;
    if (threadIdx.x == 0) (void)xb_add(&bar[XB_XCNT(b.x)], 1u);
    return b;
}
__device__ __forceinline__ void xcd_barrier_complete(unsigned* bar, unsigned x, unsigned& nloc, unsigned& nx) {
    const unsigned G = gridDim.x * gridDim.y * gridDim.z;
    unsigned sum, cnt, mine, sp = 0u;
    for (;;) {
        sum = 0u; cnt = 0u; mine = 0u;
#pragma unroll
        for (unsigned j = 0; j < 16; ++j) { const unsigned c = xb_ld(&bar[XB_XCNT(j)]); sum += c; cnt += (c > 0u) ? 1u : 0u; mine = (j == x) ? c : mine; }
        if (sum == G) break;
        __builtin_amdgcn_s_sleep(1);
        if ((++sp & 255u) == 0u) { if (xb_ld(&bar[XB_TMO])) break; if (sp > XB_SPIN_CAP) { atomicAdd(&bar[XB_TMO], 1u); break; } }
    }
    nloc = mine > 0u ? mine : 1u; nx = cnt > 0u ? cnt : 1u;
}

__device__ __forceinline__ void xcd_barrier(const XcdBarrier& b) {
    asm volatile("s_waitcnt vmcnt(0)" ::: "memory");
    __syncthreads();
    if (threadIdx.x == 0) {
        unsigned* bar = b.bar;
        __builtin_amdgcn_s_waitcnt(0);
        unsigned nloc = b.st[0], nx = b.st[1];
        if (nloc == 0u) { xcd_barrier_complete(bar, b.x, nloc, nx); b.st[0] = nloc; b.st[1] = nx; }
        const unsigned old = xb_add(&bar[XB_XSUB(b.x)], 1u);
        const unsigned gen = old / nloc;
        if (old + 1u == (gen + 1u) * nloc) {
            __builtin_amdgcn_fence(__ATOMIC_RELEASE, "agent");
            asm volatile("s_waitcnt vmcnt(0)" ::: "memory");
            const unsigned og = xb_add(&bar[XB_TOP], 1u);
            const unsigned tg = og / nx;
            if (og + 1u == (tg + 1u) * nx) xb_add(&bar[XB_TOPGEN], 1u);
            else XB_SPIN(xb_ld(&bar[XB_TOPGEN]) == tg, bar);
            __builtin_amdgcn_fence(__ATOMIC_ACQUIRE, "agent");
            xb_add(&bar[XB_XGEN(b.x)], 1u);
            asm volatile("s_waitcnt vmcnt(0)" ::: "memory");
        } else {
            XB_SPIN(xb_ld(&bar[XB_XGEN(b.x)]) == gen, bar);
            __builtin_amdgcn_fence(__ATOMIC_ACQUIRE, "agent");
            asm volatile("s_waitcnt vmcnt(0)" ::: "memory");
        }
    }
    __syncthreads();
}

struct PairOrder {
    pg8::StaticOrder base;
    __device__ __forceinline__ bool next(int i, pg8::Unit& u) const { pg8::Unit r; if (!base.next(i >> 1, r)) return false; u.pm = r.pm; u.pn = 2 * r.pn + (i & 1); return true; }
    __device__ __forceinline__ void a_ready(const pg8::Unit&) const {}
    __device__ __forceinline__ void done(const pg8::Unit&) const {}
};
__global__ void __launch_bounds__(NTHR, 2) fwd_megakernel(Args a) {
    extern __shared__ __attribute__((aligned(16))) unsigned char lds_raw[];
    LAS unsigned char* lds = (LAS unsigned char*)lds_raw;
    const int tid = threadIdx.x, lane = tid & 63, wave = __builtin_amdgcn_readfirstlane(tid >> 6);
    const int G = gridDim.x, bx = blockIdx.x;
    const int gw = bx * NWAVES + wave, NGW = G * NWAVES;
    const int lo = a.ph_lo, hi = a.ph_hi;
    cg::grid_group grid = cg::this_grid();
    if (tid < 16) ((LAS unsigned*)(lds + LDS_BAR_OFF))[tid] = 0u;
    __syncthreads();
    XcdBarrier xbar; xbar.bar = (unsigned*)(a.ws + WS_BAR); xbar.x = 0; xbar.st = (volatile LAS unsigned*)(lds + LDS_BAR_OFF);
    if (hi - lo > 1) xbar = xcd_barrier_post((unsigned*)(a.ws + WS_BAR), (volatile LAS unsigned*)(lds + LDS_BAR_OFF));
#define IN(k) (lo <= (k) && (k) < hi)
#ifndef MK_DUP
#define MK_DUP 0
#endif
#define REP(k) for (int rep_ = 0; rep_ < (((MK_DUP) >> (k)) & 1) + 1; ++rep_)
#define SEAM(k) do { if ((k) + 1 < hi) { if ((k) == 0) grid.sync(); else xcd_barrier(xbar); } } while (0)
    bf16* PROJ = (bf16*)(a.ws + WS_PROJ);
    unsigned char* dob = (unsigned char*)a.out;

    if (IN(0)) { p0_prologue(a, lds, tid, lane, wave, G); SEAM(0); }
    if (IN(1)) { p0b_mod_reduce(a, bx * NTHR + tid, G * NTHR); SEAM(1); }
#ifndef MK_XSYNC
#define MK_XSYNC 0
#endif
    if (IN(2)) for (int xs_ = 0; xs_ < MK_XSYNC; ++xs_) grid.sync();
    if (IN(2)) REP(2) { p1_prenorm(a, lane, gw, NGW); SEAM(2); }
    if (IN(3)) REP(3) {
        pg8::Gemm g{(const bf16*)(dob + DO_H), (const bf16*)(a.ws + WS_WIN), MTOK, INW, DM}; pg8::StaticOrder S; S.init(MTOK, INW, G, bx);
        pg8::EpiProj E{PROJ, (const float*)(a.ws + WS_ROPE), (bf16*)(a.ws + WS_US)};
        pg8::gemm_phase<pg8::EpiProj, pg8::StaticOrder, true, true>(lds, g, S, E);
        SEAM(3);
    }
    if (IN(4)) REP(4) {
        REP(16) retA_phase(PROJ, (bf16*)(dob + DO_XT), lds, tid, lane, wave, bx, G);
        REP(17) { int gl = -1;
          for (int bu = bx; bu < 512; bu += G) { const int g = ((bu & 7) << 3) | ((bu >> 3) & 7);
              if (g != gl) { __syncthreads(); const unsigned char* src = a.ws + WS_S5C + (size_t)g * S5C_GROUP + S5C_WE;
                  { v4u stg[8];
#pragma unroll
                    for (int i = 0; i < 8; ++i) stg[i] = *(const v4u*)(src + (size_t)(tid + NTHR * i) * 16);
#pragma unroll
                    for (int i = 0; i < 8; ++i) *(LAS v4u*)(lds + (tid + NTHR * i) * 16) = stg[i]; }
                  __syncthreads(); gl = g; }
              s5_local_state(a, (bu >> 6) * 8 + wave, g, lane, lds); }
          __syncthreads(); }
        SEAM(4);
    }
    if (IN(5)) REP(5) {
        for (int pair = bx; pair < 256; pair += G) s5_carry_scan(a, pair, lane, wave, lds);
        retB_scan((const bf16*)(dob + DO_XT), (bf16*)(dob + DO_TT), bx * NTHR + tid, G * NTHR);
        __syncthreads();
        SEAM(5);
    }
    if (IN(6)) REP(6) {
        REP(18) retC_phase(PROJ, (const bf16*)(dob + DO_TT), (bf16*)(dob + DO_A2), lds, tid, lane, wave, bx, G);
        REP(19) { int gl = -1;
          for (int bu = bx; bu < 512; bu += G) { const int g = ((bu & 7) << 3) | ((bu >> 3) & 7);
              if (g != gl) { __syncthreads(); const unsigned char* src = a.ws + WS_S5C + (size_t)g * S5C_GROUP;
                  { v4u stg[10];
#pragma unroll
                    for (int i = 0; i < 10; ++i) stg[i] = *(const v4u*)(src + (size_t)(tid + NTHR * i) * 16);
#pragma unroll
                    for (int i = 0; i < 10; ++i) *(LAS v4u*)(lds + (tid + NTHR * i) * 16) = stg[i]; }
                  __syncthreads(); gl = g; }
              s5_output(a, (bu >> 6) * 8 + wave, g, lane, lds); }
          __syncthreads(); }
        SEAM(6);
    }
    if (IN(7)) REP(7) {
        pg8::StaticOrder SR; SR.init(MTOK, DM, G, bx);
        { pg8::Gemm g{(const bf16*)(a.ws + WS_YS), (const bf16*)(a.ws + WS_WGLU), MTOK, 4096, 1024}; PairOrder S{SR};
          pg8::EpiPair<true> E{(bf16*)(dob + DO_MS), DM, PROJ, GS_OFF};
          pg8::gemm_phase<pg8::EpiPair<true>, PairOrder, true, true>(lds, g, S, E); }
        asm volatile("s_waitcnt vmcnt(0)" ::: "memory"); __syncthreads();
        { pg8::Gemm g{(const bf16*)(dob + DO_A2), (const bf16*)(a.ws + WS_WRET), MTOK, DM, DM};
          pg8::EpiMerge E{(bf16*)(a.ws + WS_MERGED), PROJ, (const bf16*)(dob + DO_MS)};
          pg8::gemm_phase<pg8::EpiMerge, pg8::StaticOrder, true, true>(lds, g, SR, E); }
        SEAM(7);
    }
    if (IN(9)) REP(9) {
        pg8::Gemm g{(const bf16*)(a.ws + WS_MERGED), (const bf16*)(a.ws + WS_WOUT), MTOK, DM, DM}; pg8::StaticOrder S; S.init(MTOK, DM, G, bx);
        pg8::EpiPlain E{(bf16*)(a.ws + WS_Y1), DM};
        pg8::gemm_phase<pg8::EpiPlain, pg8::StaticOrder, true, true>(lds, g, S, E);
        SEAM(9);
    }
    if (IN(10)) REP(10) {
        p8_mid(a, lane, gw, NGW);
        LAS float* scr = (LAS float*)(lds + wave * 16384);
        constexpr int I_FIN = (DM / 64) * (INW / 32), I_FOUT = (DFF / 64) * (DM / 32);
        for (int it = gw; it < I_FIN + I_FOUT; it += NGW) {
            if (it < I_FIN) transpose_item(a.in[17], DM, INW, (bf16*)(a.ws + WS_WFIN), PERM_PAIR, DFF, scr, it, lane);
            else transpose_item(a.in[18], DFF, DM, (bf16*)(a.ws + WS_WFOUT), PERM_NONE, 0, scr, it - I_FIN, lane); }
        __syncthreads();
        SEAM(10);
    }
    if (IN(11)) REP(11) {
        pg8::Gemm g{(const bf16*)(a.ws + WS_H2), (const bf16*)(a.ws + WS_WFIN), MTOK, INW, DM}; pg8::StaticOrder S; S.init(MTOK, INW, G, bx);
        pg8::EpiPair<false> E{(bf16*)(a.ws + WS_ACT), DFF, nullptr, 0};
        pg8::gemm_phase<pg8::EpiPair<false>, pg8::StaticOrder, true, true>(lds, g, S, E);
        SEAM(11);
    }
    if (IN(12)) REP(12) {
        pg8::Gemm g{(const bf16*)(a.ws + WS_ACT), (const bf16*)(a.ws + WS_WFOUT), MTOK, DM, DFF}; pg8::StaticOrder S; S.init(MTOK, DM, G, bx);
        pg8::EpiPlain E{(bf16*)(a.ws + WS_Y2), DM};
        pg8::gemm_phase<pg8::EpiPlain, pg8::StaticOrder, true, true>(lds, g, S, E);
        SEAM(12);
    }
    if (IN(13)) { p11_final(a, lane, gw, NGW); }
#undef IN
#undef SEAM
}

extern "C" void kernel_launch(void* const* d_in, const int* in_sizes, int n_in, void* d_out, int out_size, void* d_ws, size_t ws_size, hipStream_t stream) {
    static int grid = 0;
    if (grid == 0) {
        if (n_in != 19 || out_size != MTOK * DM || ws_size < WS_END) { fprintf(stderr, "kernel_launch: unexpected problem (n_in %d out %d ws %zu)\n", n_in, out_size, ws_size); grid = -1; return; }
        int dev = 0, cus = 0, per_cu = 0;
        (void)hipGetDevice(&dev); (void)hipDeviceGetAttribute(&cus, hipDeviceAttributeMultiprocessorCount, dev);
        if (hipFuncSetAttribute((const void*)fwd_megakernel, hipFuncAttributeMaxDynamicSharedMemorySize, LDS_BYTES) != hipSuccess) { fprintf(stderr, "kernel_launch: hipFuncSetAttribute failed\n"); grid = -1; return; }
        if (hipOccupancyMaxActiveBlocksPerMultiprocessor(&per_cu, (const void*)fwd_megakernel, NTHR, LDS_BYTES) != hipSuccess || per_cu < 1) { fprintf(stderr, "kernel_launch: occupancy query failed (%d)\n", per_cu); (void)hipGetLastError(); per_cu = 1; }
        if (per_cu > 1) per_cu = 1;
        grid = cus * per_cu;
    }
    if (grid < 0) return;
    (void)hipMemsetAsync((unsigned char*)d_ws + WS_MOD, 0, CTL_ZERO_BYTES, stream);
    Args a{};
    for (int i = 0; i < 19; ++i) a.in[i] = (const float*)d_in[i];
    a.out = (float*)d_out; a.ws = (unsigned char*)d_ws;
#if MK_PER_PHASE
    for (int p = 0; p <= N_PHASES; ++p) { a.ph_lo = p; a.ph_hi = p + 1; hipLaunchKernelGGL(fwd_megakernel, dim3(grid), dim3(NTHR), LDS_BYTES, stream, a); }
#else
    a.ph_lo = 0; a.ph_hi = N_PHASES + 1;
    void* args[] = {&a};
    hipError_t e = hipLaunchCooperativeKernel((const void*)fwd_megakernel, dim3(grid), dim3(NTHR), args, LDS_BYTES, stream);
    if (e != hipSuccess) fprintf(stderr, "kernel_launch: cooperative launch failed: %s (grid %d)\n", hipGetErrorString(e), grid);
#endif
}
```

```cpp
#include <hip/hip_runtime.h>
#include <hip/hip_cooperative_groups.h>
#include <cstdio>
#include <cstdint>
#include <cmath>
namespace cg = cooperative_groups;
#ifndef MK_PER_PHASE
#define MK_PER_PHASE 0
#endif
namespace pg8 {
#define PG8_LAS __attribute__((address_space(3)))
typedef unsigned short bf16_t;
typedef short bf16x8 __attribute__((ext_vector_type(8)));
typedef float f32x4 __attribute__((ext_vector_type(4)));
typedef unsigned u32x4 __attribute__((ext_vector_type(4)));
constexpr int BM = 256, BK = 64, HALF = 128, HTB = HALF * BK * 2  , STAGE_BYTES = 8 * HTB, NXCD = 8, WGM = 4;

__host__ __device__ __forceinline__ int lds_byte(int r, int c) { const int st = (r >> 4) * 2 + (c >> 5), rr = r & 15, cc = c & 31, ob = rr * 64 + cc * 2; return st * 1024 + (ob ^ (((ob >> 9) & 1) << 5)); }
__host__ __device__ __forceinline__ void stage_rc(int b, int& R, int& C) { const int st = b / 1024, sb = b % 1024, swz = sb ^ (((sb >> 9) & 1) << 5); R = (st >> 1) * 16 + swz / 64; C = (st & 1) * 32 + (swz % 64) / 2; }
__host__ __device__ __forceinline__ int perm32(int rho) { const int n = rho >> 4, i = rho & 15; return 8 * (i >> 2) + 4 * n + (i & 3); }

struct Unit { int pm, pn; };
struct Gemm { const bf16_t* A; const bf16_t* Bt; int M, N, K; };

struct StaticOrder {
    int nM, nN, nwg, G, c;
    __host__ __device__ void init(int M, int N, int G_, int c_) { nM = M / BM; nN = N / BM; nwg = nM * nN; G = G_; c = c_; }
    __host__ __device__ bool next(int i, Unit& u) const {
        const long L = (long)i * G + c; if (L >= nwg) return false;
        int wgid = (int)L; { const int q = nwg / NXCD, r = nwg % NXCD, xcd = wgid % NXCD, off = wgid / NXCD; wgid = (xcd < r ? xcd * (q + 1) : r * (q + 1) + (xcd - r) * q) + off; }
        const int nig = WGM * nN, gid = wgid / nig, fm = gid * WGM, gsz = (nM - fm) < WGM ? (nM - fm) : WGM;
        u.pm = fm + ((wgid % nig) % gsz); u.pn = (wgid % nig) / gsz; return true;
    }
    __device__ __forceinline__ void a_ready(const Unit&) const {}
    __device__ __forceinline__ void done(const Unit&) const {}
};

__device__ __forceinline__ unsigned cvt_pk_bf16(float lo, float hi) { unsigned r; asm volatile("v_cvt_pk_bf16_f32 %0, %1, %2" : "=v"(r) : "v"(lo), "v"(hi)); return r; }
typedef unsigned u32x2 __attribute__((ext_vector_type(2)));
__device__ __forceinline__ float bf_lo(unsigned w) { return __uint_as_float(w << 16); }
__device__ __forceinline__ float bf_hi(unsigned w) { return __uint_as_float(w & 0xffff0000u); }
__device__ __forceinline__ float fast_sigmoid(float x) { return __builtin_amdgcn_rcpf(1.0f + __expf(-x)); }
__device__ __forceinline__ float fast_silu(float x) { return x * fast_sigmoid(x); }
__device__ __forceinline__ float lg2_gamma(int h) {
    return h == 0 ? -0.04580368961312479f : h == 1 ? -0.02272007650008353f : h == 2 ? -0.011315313227834146f : h == 3 ? -0.005646563141142062f :
           h == 4 ? -0.002820519062378663f : h == 5 ? -0.0014095702546713536f : h == 6 ? -0.0007046129765893728f : -0.00035226347162902144f;
}
constexpr int PJ_INW = 10240, PJ_G = 4096, PJ_GR = 6144, PJ_GS = 8192, PJ_MTOK = 16384;

struct EpiProj {
    static constexpr bool PERM = true, AFTER_DRAIN = false;
    bf16_t* O; const float* rope; bf16_t* US;
    __device__ __forceinline__ void operator()(const f32x4 (&acc)[2][2][4][2], const Unit& u, int wr, int wc, int fr, int fq) const {
        const int pn = u.pn, row0 = u.pm * BM + wr * 64 + fr, colb = pn * BM + wc * 32 + 8 * fq;
        if (pn < 8) {
            const bool isk = pn >= 4; const int f0 = 4 * (4 * wc + fq);
#pragma unroll
            for (int ai = 0; ai < 2; ++ai)
#pragma unroll
                for (int m = 0; m < 4; ++m) {
                    const int row = row0 + ai * HALF + m * 16, pos = row & 4095; const float cpos = (float)(pos & 127);
                    const f32x4 cs = *(const f32x4*)(rope + pos * 64 + f0), sn = *(const f32x4*)(rope + 262144 + pos * 64 + f0);
#pragma unroll
                    for (int bj = 0; bj < 2; ++bj) {
                        const float l2 = lg2_gamma((pn & 3) * 2 + bj);
                        const float sc = isk ? __builtin_amdgcn_exp2f(-cpos * l2) * 0.08838834764831845f : __builtin_amdgcn_exp2f(cpos * l2);
                        const f32x4 v0 = acc[ai][bj][m][0], v1 = acc[ai][bj][m][1];
                        const f32x4 o1 = (v0 * cs - v1 * sn) * sc, o2 = (v0 * sn + v1 * cs) * sc;
                        u32x4 w; w.x = cvt_pk_bf16(o1[0], o1[1]); w.y = cvt_pk_bf16(o1[2], o1[3]); w.z = cvt_pk_bf16(o2[0], o2[1]); w.w = cvt_pk_bf16(o2[2], o2[3]);
                        *(u32x4*)(O + (size_t)row * PJ_INW + colb + bj * HALF) = w;
                    }
                }
        } else {
            const int mode = (pn >= 16 && pn < 24) ? 1 : (pn >= 28 ? 2 : 0);
            const bool isu = pn >= 24 && pn < 28;
            const int ocol = (pn >= 28 ? (pn - 4) : pn) * BM + wc * 32 + 8 * fq, ucol = (pn - 24) * BM + wc * 32 + 8 * fq;
#pragma unroll
            for (int ai = 0; ai < 2; ++ai)
#pragma unroll
                for (int m = 0; m < 4; ++m) {
                    const int row = row0 + ai * HALF + m * 16;
#pragma unroll
                    for (int bj = 0; bj < 2; ++bj) {
                        f32x4 v0 = acc[ai][bj][m][0], v1 = acc[ai][bj][m][1];
                        if (mode == 1) {
#pragma unroll
                            for (int i = 0; i < 4; ++i) { v0[i] = fast_silu(v0[i]); v1[i] = fast_silu(v1[i]); }
                        } else if (mode == 2) {
#pragma unroll
                            for (int i = 0; i < 4; ++i) { v0[i] = fast_sigmoid(v0[i]); v1[i] = fast_sigmoid(v1[i]); }
                        }
                        u32x4 w; w.x = cvt_pk_bf16(v0[0], v0[1]); w.y = cvt_pk_bf16(v0[2], v0[3]); w.z = cvt_pk_bf16(v1[0], v1[1]); w.w = cvt_pk_bf16(v1[2], v1[3]);
                        if (isu) { const int cu = ucol + bj * HALF; *(u32x4*)(US + ((size_t)(cu >> 4) * PJ_MTOK + row) * 16 + (cu & 8)) = w; }
                        else *(u32x4*)(O + (size_t)row * PJ_INW + ocol + bj * HALF) = w;
                    }
                }
        }
    }
};
struct EpiPlain {
    static constexpr bool PERM = true, AFTER_DRAIN = false;
    bf16_t* O; int ldc;
    __device__ __forceinline__ void operator()(const f32x4 (&acc)[2][2][4][2], const Unit& u, int wr, int wc, int fr, int fq) const {
        const int row0 = u.pm * BM + wr * 64 + fr, colb = u.pn * BM + wc * 32 + 8 * fq;
#pragma unroll
        for (int ai = 0; ai < 2; ++ai)
#pragma unroll
            for (int m = 0; m < 4; ++m) {
                const int row = row0 + ai * HALF + m * 16;
#pragma unroll
                for (int bj = 0; bj < 2; ++bj) {
                    const f32x4 v0 = acc[ai][bj][m][0], v1 = acc[ai][bj][m][1];
                    u32x4 w; w.x = cvt_pk_bf16(v0[0], v0[1]); w.y = cvt_pk_bf16(v0[2], v0[3]); w.z = cvt_pk_bf16(v1[0], v1[1]); w.w = cvt_pk_bf16(v1[2], v1[3]);
                    *(u32x4*)(O + (size_t)row * ldc + colb + bj * HALF) = w;
                }
            }
    }
};
template <bool GATED> struct EpiPair {
    static constexpr bool PERM = true, AFTER_DRAIN = false;
    bf16_t* O; int ldc; const bf16_t* gate; int gate_off;
    __device__ __forceinline__ void operator()(const f32x4 (&acc)[2][2][4][2], const Unit& u, int wr, int wc, int fr, int fq) const {
        const int row0 = u.pm * BM + wr * 64 + fr, o = u.pn * HALF + wc * 32 + 8 * fq;
#pragma unroll
        for (int ai = 0; ai < 2; ++ai)
#pragma unroll
            for (int m = 0; m < 4; ++m) {
                const int row = row0 + ai * HALF + m * 16;
                const f32x4 a0 = acc[ai][0][m][0], a1 = acc[ai][0][m][1], b0 = acc[ai][1][m][0], b1 = acc[ai][1][m][1];
                f32x4 r0, r1;
                if (GATED) {
                    const u32x4 g = __builtin_nontemporal_load((const u32x4*)(gate + (size_t)row * PJ_INW + gate_off + o));
                    r0[0] = a0[0] * fast_sigmoid(b0[0]) * bf_lo(g.x); r0[1] = a0[1] * fast_sigmoid(b0[1]) * bf_hi(g.x);
                    r0[2] = a0[2] * fast_sigmoid(b0[2]) * bf_lo(g.y); r0[3] = a0[3] * fast_sigmoid(b0[3]) * bf_hi(g.y);
                    r1[0] = a1[0] * fast_sigmoid(b1[0]) * bf_lo(g.z); r1[1] = a1[1] * fast_sigmoid(b1[1]) * bf_hi(g.z);
                    r1[2] = a1[2] * fast_sigmoid(b1[2]) * bf_lo(g.w); r1[3] = a1[3] * fast_sigmoid(b1[3]) * bf_hi(g.w);
                } else {
#pragma unroll
                    for (int i = 0; i < 4; ++i) { r0[i] = fast_silu(a0[i]) * b0[i]; r1[i] = fast_silu(a1[i]) * b1[i]; }
                }
                u32x4 w; w.x = cvt_pk_bf16(r0[0], r0[1]); w.y = cvt_pk_bf16(r0[2], r0[3]); w.z = cvt_pk_bf16(r1[0], r1[1]); w.w = cvt_pk_bf16(r1[2], r1[3]);
                *(u32x4*)(O + (size_t)row * ldc + o) = w;
            }
    }
};
struct EpiMerge {
    static constexpr bool PERM = true, AFTER_DRAIN = false;
    bf16_t* O; const bf16_t* proj; const bf16_t* ms;
    __device__ __forceinline__ void operator()(const f32x4 (&acc)[2][2][4][2], const Unit& u, int wr, int wc, int fr, int fq) const {
        const int row0 = u.pm * BM + wr * 64 + fr, colb = u.pn * BM + wc * 32 + 8 * fq;
#pragma unroll
        for (int ai = 0; ai < 2; ++ai)
#pragma unroll
            for (int m = 0; m < 4; ++m) {
                const int row = row0 + ai * HALF + m * 16;
#pragma unroll
                for (int bj = 0; bj < 2; ++bj) {
                    const int col = colb + bj * HALF;
                    const u32x4 g = __builtin_nontemporal_load((const u32x4*)(proj + (size_t)row * PJ_INW + PJ_GR + col)), s = __builtin_nontemporal_load((const u32x4*)(ms + (size_t)row * 2048 + col));
                    const f32x4 v0 = acc[ai][bj][m][0], v1 = acc[ai][bj][m][1];
                    u32x4 w;
                    w.x = cvt_pk_bf16(v0[0] * bf_lo(g.x) + bf_lo(s.x), v0[1] * bf_hi(g.x) + bf_hi(s.x));
                    w.y = cvt_pk_bf16(v0[2] * bf_lo(g.y) + bf_lo(s.y), v0[3] * bf_hi(g.y) + bf_hi(s.y));
                    w.z = cvt_pk_bf16(v1[0] * bf_lo(g.z) + bf_lo(s.z), v1[1] * bf_hi(g.z) + bf_hi(s.z));
                    w.w = cvt_pk_bf16(v1[2] * bf_lo(g.w) + bf_lo(s.w), v1[3] * bf_hi(g.w) + bf_hi(s.w));
                    *(u32x4*)(O + (size_t)row * 2048 + col) = w;
                }
            }
    }
};
template <class Epi, class Sched, bool ALIGN_EPI = false, bool SP2 = false>
__device__ __forceinline__ void gemm_phase(PG8_LAS unsigned char* lds, const Gemm g, const Sched& S, const Epi& E) {
    const int tid = threadIdx.x, wid = __builtin_amdgcn_readfirstlane(tid >> 6), lane = tid & 63, wr = wid >> 2, wc = wid & 3, fr = lane & 15, fq = lane >> 4;
    const int K = g.K, nt = K / BK;
    unsigned voffA[2], voffB[2];
#pragma unroll
    for (int i = 0; i < 2; ++i) { int R, C; stage_rc(tid * 16 + i * 8192, R, C); const int Rb = Epi::PERM ? ((R & ~31) + perm32(R & 31)) : R;
        voffA[i] = (unsigned)(R * K + C) * 2u; voffB[i] = (unsigned)(Rb * K + C) * 2u; }
    const size_t kstep = (size_t)(BK * 2);
    const size_t hstep = (size_t)HALF * K * 2;
    const size_t tstep = 2 * hstep;
    const unsigned ldsw = (unsigned)wid * 1024u;
    const int aoff = lds_byte(wr * 64 + fr, fq * 8), boff = lds_byte(wc * 32 + fr, fq * 8);
#define PG8_SA(b, h) (((b) * 2 + (h)) * HTB)
#define PG8_SB(b, h) ((4 + (b) * 2 + (h)) * HTB)
#define PG8_STAGE(bufoff, gbase, voff) do { _Pragma("unroll") for (int _i = 0; _i < 2; ++_i) \
        __builtin_amdgcn_global_load_lds((const unsigned*)((const char*)(gbase) + (voff)[_i]), (PG8_LAS unsigned*)(lds + (bufoff) + ldsw + _i * 8192), 16, 0, 0); } while (0)
#define PG8_LDA(dst, b, h) do { _Pragma("unroll") for (int m = 0; m < 4; ++m) _Pragma("unroll") for (int k = 0; k < 2; ++k) dst[m][k] = *(const PG8_LAS bf16x8*)(lds + PG8_SA(b, h) + aoff + m * 2048 + k * 1024); } while (0)
#define PG8_LDB(dst, b, h) do { _Pragma("unroll") for (int n = 0; n < 2; ++n) _Pragma("unroll") for (int k = 0; k < 2; ++k) dst[n][k] = *(const PG8_LAS bf16x8*)(lds + PG8_SB(b, h) + boff + n * 2048 + k * 1024); } while (0)
#define PG8_MMA(ai, bj, At, Bt) do { __builtin_amdgcn_s_setprio(1); _Pragma("unroll") for (int m = 0; m < 4; ++m) _Pragma("unroll") for (int n = 0; n < 2; ++n) _Pragma("unroll") for (int k = 0; k < 2; ++k) \
        acc[ai][bj][m][n] = __builtin_amdgcn_mfma_f32_16x16x32_bf16(Bt[n][k], At[m][k], acc[ai][bj][m][n], 0, 0, 0); __builtin_amdgcn_s_setprio(0); } while (0)
#define PG8_WAIT_V(n) asm volatile("s_waitcnt vmcnt(" #n ")" ::: "memory")
#define PG8_WAIT_L(n) asm volatile("s_waitcnt lgkmcnt(" #n ")" ::: "memory")
#define PG8_BAR __builtin_amdgcn_s_barrier()
#define PG8_SCHED __builtin_amdgcn_sched_barrier(0)
    Unit cur, nxt; int ui = 0;
    if (!S.next(0, cur)) return;
    f32x4 acc[2][2][4][2];
#pragma unroll
    for (int a = 0; a < 2; ++a)
#pragma unroll
        for (int b = 0; b < 2; ++b)
#pragma unroll
            for (int m = 0; m < 4; ++m)
#pragma unroll
                for (int n = 0; n < 2; ++n) acc[a][b][m][n] = (f32x4){0.f, 0.f, 0.f, 0.f};
    bf16x8 At[4][2], B0[2][2], B1[2][2];
    const char* cA = (const char*)g.A + (size_t)cur.pm * tstep; const char* cB = (const char*)g.Bt + (size_t)cur.pn * tstep;
    S.a_ready(cur);
    if constexpr (SP2) {
        PG8_STAGE(PG8_SB(0, 0), cB, voffB); PG8_STAGE(PG8_SB(0, 1), cB + hstep, voffB); PG8_STAGE(PG8_SA(0, 0), cA, voffA); PG8_STAGE(PG8_SA(0, 1), cA + hstep, voffA);
        if (wr == 1) PG8_BAR;
        PG8_WAIT_V(2); PG8_BAR;
        PG8_STAGE(PG8_SB(1, 0), cB + kstep, voffB); PG8_STAGE(PG8_SA(1, 0), cA + kstep, voffA); PG8_STAGE(PG8_SB(1, 1), cB + hstep + kstep, voffB);
        PG8_WAIT_V(6); PG8_BAR;
    } else {
        PG8_STAGE(PG8_SB(0, 0), cB, voffB); PG8_STAGE(PG8_SA(0, 0), cA, voffA); PG8_STAGE(PG8_SB(0, 1), cB + hstep, voffB); PG8_STAGE(PG8_SA(0, 1), cA + hstep, voffA);
        if (wr == 1) PG8_BAR;
        PG8_WAIT_V(4); PG8_BAR;
        PG8_STAGE(PG8_SB(1, 0), cB + kstep, voffB); PG8_STAGE(PG8_SA(1, 0), cA + kstep, voffA); PG8_STAGE(PG8_SB(1, 1), cB + hstep + kstep, voffB);
        PG8_WAIT_V(6); PG8_BAR;
    }
    for (;;) {
        const bool has_next = S.next(ui + 1, nxt);
        const char* nA = has_next ? (const char*)g.A + (size_t)nxt.pm * tstep : cA; const char* nB = has_next ? (const char*)g.Bt + (size_t)nxt.pn * tstep : cB;
        for (int t = 0; t < nt; t += 2) {
            const bool last = (t == nt - 2);
            const char* a1 = cA + (size_t)(t + 1) * kstep;
            const char* a2 = last ? nA : cA + (size_t)(t + 2) * kstep; const char* b2 = last ? nB : cB + (size_t)(t + 2) * kstep;
            const char* a3 = a2 + kstep; const char* b3 = b2 + kstep;
            if (last && has_next) S.a_ready(nxt);
            if constexpr (SP2) {
            PG8_LDB(B0, 0, 0); PG8_LDB(B1, 0, 1); PG8_SCHED; PG8_LDA(At, 0, 0); PG8_STAGE(PG8_SA(1, 1), a1 + hstep, voffA);
            PG8_WAIT_V(8); PG8_WAIT_L(0); PG8_BAR; PG8_MMA(0, 0, At, B0); PG8_MMA(0, 1, At, B1); PG8_BAR; PG8_SCHED;
            PG8_LDA(At, 0, 1); PG8_STAGE(PG8_SB(0, 0), b2, voffB); PG8_STAGE(PG8_SB(0, 1), b2 + hstep, voffB); PG8_STAGE(PG8_SA(0, 0), a2, voffA);
            PG8_WAIT_V(8); PG8_WAIT_L(0); PG8_BAR; PG8_MMA(1, 0, At, B0); PG8_MMA(1, 1, At, B1); PG8_BAR; PG8_SCHED;
            PG8_LDB(B0, 1, 0); PG8_LDB(B1, 1, 1); PG8_SCHED; PG8_LDA(At, 1, 0); PG8_STAGE(PG8_SA(0, 1), a2 + hstep, voffA);
            PG8_WAIT_V(8); PG8_WAIT_L(0); PG8_BAR; PG8_MMA(0, 0, At, B0); PG8_MMA(0, 1, At, B1); PG8_BAR; PG8_SCHED;
            PG8_LDA(At, 1, 1); PG8_STAGE(PG8_SB(1, 0), b3, voffB); PG8_STAGE(PG8_SB(1, 1), b3 + hstep, voffB); PG8_STAGE(PG8_SA(1, 0), a3, voffA);
            PG8_WAIT_V(8); PG8_WAIT_L(0); PG8_BAR; PG8_MMA(1, 0, At, B0); PG8_MMA(1, 1, At, B1); PG8_BAR; PG8_SCHED;
            } else {
            PG8_LDB(B0, 0, 0); PG8_SCHED; PG8_LDA(At, 0, 0); PG8_STAGE(PG8_SA(1, 1), a1 + hstep, voffA);
            PG8_WAIT_L(8); PG8_BAR; PG8_WAIT_L(0); PG8_MMA(0, 0, At, B0); PG8_BAR; PG8_SCHED;
            PG8_LDB(B1, 0, 1); PG8_STAGE(PG8_SB(0, 0), b2, voffB);
            PG8_BAR; PG8_WAIT_L(0); PG8_MMA(0, 1, At, B1); PG8_BAR;
            PG8_LDA(At, 0, 1); PG8_STAGE(PG8_SA(0, 0), a2, voffA);
            PG8_BAR; PG8_WAIT_L(0); PG8_MMA(1, 0, At, B0); PG8_BAR; PG8_SCHED;
            PG8_STAGE(PG8_SB(0, 1), b2 + hstep, voffB);
            PG8_WAIT_V(6); PG8_BAR; PG8_MMA(1, 1, At, B1); PG8_BAR;
            PG8_LDB(B0, 1, 0); PG8_SCHED; PG8_LDA(At, 1, 0); PG8_STAGE(PG8_SA(0, 1), a2 + hstep, voffA);
            PG8_WAIT_L(8); PG8_BAR; PG8_WAIT_L(0); PG8_MMA(0, 0, At, B0); PG8_BAR; PG8_SCHED;
            PG8_LDB(B1, 1, 1); PG8_STAGE(PG8_SB(1, 0), b3, voffB);
            PG8_BAR; PG8_WAIT_L(0); PG8_MMA(0, 1, At, B1); PG8_BAR;
            PG8_LDA(At, 1, 1); PG8_STAGE(PG8_SA(1, 0), a3, voffA);
            PG8_BAR; PG8_WAIT_L(0); PG8_MMA(1, 0, At, B0); PG8_BAR; PG8_SCHED;
            PG8_STAGE(PG8_SB(1, 1), b3 + hstep, voffB);
            PG8_WAIT_V(6); PG8_BAR; PG8_MMA(1, 1, At, B1); PG8_BAR;
            }
        }
        if constexpr (ALIGN_EPI) { if (wr == 0) PG8_BAR; }
        if constexpr (!Epi::AFTER_DRAIN) { E(acc, cur, wr, wc, fr, fq); S.done(cur); }
        if (!has_next) break;
#pragma unroll
        for (int a = 0; a < 2; ++a)
#pragma unroll
            for (int b = 0; b < 2; ++b)
#pragma unroll
                for (int m = 0; m < 4; ++m)
#pragma unroll
                    for (int n = 0; n < 2; ++n) acc[a][b][m][n] = (f32x4){0.f, 0.f, 0.f, 0.f};
        cur = nxt; cA = nA; cB = nB; ++ui;
        if constexpr (ALIGN_EPI) { if (wr == 1) PG8_BAR; }
    }
    PG8_WAIT_V(0);
    if constexpr (!ALIGN_EPI) { if (wr == 0) PG8_BAR; }
    PG8_BAR;
    if constexpr (Epi::AFTER_DRAIN) { E.fused(acc, cur, wr, wc, fr, fq, lds, wid, lane); S.done(cur); }
#undef PG8_SA
#undef PG8_SB
#undef PG8_STAGE
#undef PG8_LDA
#undef PG8_LDB
#undef PG8_MMA
#undef PG8_WAIT_V
#undef PG8_WAIT_L
#undef PG8_BAR
#undef PG8_SCHED
}
}

#define LAS __attribute__((address_space(3)))
typedef unsigned short bf16;
typedef unsigned v4u __attribute__((ext_vector_type(4)));
typedef unsigned v2u __attribute__((ext_vector_type(2)));
typedef float f32x4 __attribute__((ext_vector_type(4)));
typedef float f32x2 __attribute__((ext_vector_type(2)));
typedef short bf16x8 __attribute__((ext_vector_type(8)));
typedef short s16x4 __attribute__((ext_vector_type(4)));
constexpr int NWAVES = 8, NTHR = 512;
constexpr int MTOK = 16384, DM = 2048, INW = 11264, DFF = 5632, SEQL = 4096;
constexpr int PJW = 10240;
constexpr int Q_OFF = 0, K_OFF = 1024, V_OFF = 2048, G_OFF = 4096, GR_OFF = 6144, GS_OFF = 8192;
constexpr size_t MiB = (size_t)1 << 20;
constexpr size_t WS_PROJ = 0;
constexpr size_t WS_US = 320 * MiB;
constexpr size_t WS_WIN = 352 * MiB;
constexpr size_t WS_YS = WS_WIN;
constexpr size_t WS_WRET = 396 * MiB, WS_WGLU = 404 * MiB, WS_WOUT = 412 * MiB;
constexpr size_t WS_TAIL = 420 * MiB;
constexpr size_t WS_E = WS_TAIL;
constexpr size_t WS_XS = WS_TAIL + 32 * MiB;
constexpr size_t WS_MERGED = WS_TAIL;
constexpr size_t WS_X1B = WS_TAIL;
constexpr size_t WS_MOD = WS_TAIL + 64 * MiB;
constexpr size_t MOD_BYTES = 4 * 12288 * 8;
constexpr size_t WS_MODF = WS_TAIL + 64 * MiB + 512 * 1024;
constexpr size_t WS_BAR = WS_TAIL + 64 * MiB + 768 * 1024;
constexpr size_t CTL_ZERO_BYTES = 1 * MiB;
constexpr int LDS_BAR_OFF = 147456 - 64;
constexpr size_t WS_ROPE = WS_TAIL + 65 * MiB;
constexpr size_t WS_S5C = WS_TAIL + 67 * MiB;
constexpr size_t S5C_GROUP = 147456, S5C_WY = 16384, S5C_WE = 81920;
constexpr size_t WS_LBT = WS_TAIL + 76 * MiB;
constexpr size_t WS_PART = WS_TAIL + 78 * MiB;
constexpr size_t WS_END = WS_TAIL + 87 * MiB;
constexpr size_t WS_Y1 = 0;
constexpr size_t WS_ACT = 0;
constexpr size_t WS_H2 = 176 * MiB;
constexpr size_t WS_Y2 = 176 * MiB;
constexpr size_t WS_WFIN = 240 * MiB;
constexpr size_t WS_WFOUT = 284 * MiB;
constexpr size_t DO_H = 0, DO_XT = 0, DO_A2 = 0, DO_TT = 64 * MiB, DO_MS = 64 * MiB;
constexpr int LDS_BYTES = 147456;
constexpr int N_PHASES = 13;

#define LDS_WAIT() asm volatile("s_waitcnt lgkmcnt(0)" ::: "memory")
__device__ __forceinline__ unsigned f2bf(float f) { unsigned u = __builtin_bit_cast(unsigned, f); return (u + 0x7fffu + ((u >> 16) & 1u)) >> 16; }
__device__ __forceinline__ unsigned pk2(float lo, float hi) { return f2bf(lo) | (f2bf(hi) << 16); }
__device__ __forceinline__ float bflo(unsigned w) { return __uint_as_float(w << 16); }
__device__ __forceinline__ float bfhi(unsigned w) { return __uint_as_float(w & 0xffff0000u); }
__device__ __forceinline__ float wave_sum(float v) {
#pragma unroll
    for (int o = 1; o < 64; o <<= 1) v += __shfl_xor(v, o);
    return v;
}
#define MFMA16(a, b, c) __builtin_amdgcn_mfma_f32_16x16x32_bf16((a), (b), (c), 0, 0, 0)
__device__ __forceinline__ bf16x8 tr_frag(LAS unsigned char* img, int pitch, int krow0, int col0, int lane_off) {
    LAS unsigned char* p = img + krow0 * pitch + col0 * 2 + lane_off;
    const s16x4 lo = __builtin_bit_cast(s16x4, __builtin_amdgcn_ds_read_tr16_b64_v4i16((LAS s16x4*)p));
    const s16x4 hi = __builtin_bit_cast(s16x4, __builtin_amdgcn_ds_read_tr16_b64_v4i16((LAS s16x4*)(p + 4 * pitch)));
    return __builtin_shufflevector(lo, hi, 0, 1, 2, 3, 4, 5, 6, 7);
}

struct Args { const float* in[19]; float* out; unsigned char* ws; int ph_lo, ph_hi; };

enum { PERM_NONE = 0, PERM_WIN = 1, PERM_PAIR = 2 };
__device__ __forceinline__ int dest_row(int mode, int n, int halfN) {
    if (mode == PERM_WIN) { if (n >= 2048) return n; const int d = n & 127, dd = d & 63; return (n & ~127) + 8 * (dd >> 2) + 4 * (d >> 6) + (dd & 3); }
    if (mode == PERM_PAIR) { const int nn = n >= halfN ? 1 : 0, o = n - nn * halfN; return 256 * (o >> 7) + 128 * nn + (o & 127); }
    return n;
}
__device__ __forceinline__ void transpose_item(const float* W, int K, int N, bf16* WT, int mode, int halfN, LAS float* scr, int item, int lane) {
    const int nblk = N / 32, kb = item / nblk, nb = item % nblk, k0 = 64 * kb, n0 = 32 * nb;
#pragma unroll
    for (int i = 0; i < 32; ++i) { const int kk = 2 * i + (lane >> 5); scr[kk * 33 + (lane & 31)] = __builtin_nontemporal_load(W + (size_t)(k0 + kk) * N + n0 + (lane & 31)); }
    LDS_WAIT(); asm volatile("" ::: "memory");
    const int c = lane & 7;
#pragma unroll
    for (int j = 0; j < 4; ++j) { const int n = (lane >> 3) + 8 * j; const LAS float* s = scr + (8 * c) * 33 + n;
        v4u o; o.x = pk2(s[0 * 33], s[1 * 33]); o.y = pk2(s[2 * 33], s[3 * 33]); o.z = pk2(s[4 * 33], s[5 * 33]); o.w = pk2(s[6 * 33], s[7 * 33]);
        *(v4u*)(WT + (size_t)dest_row(mode, n0 + n, halfN) * K + k0 + 8 * c) = o; }
    LDS_WAIT(); asm volatile("" ::: "memory");
}
__device__ __forceinline__ void sincos_rev(double rev, float& s, float& c) {
    const float f = (float)(rev - rint(rev));
    s = __builtin_amdgcn_sinf(f); c = __builtin_amdgcn_cosf(f);
}
constexpr double INV_2PI = 0.15915494309189533577;

__device__ __forceinline__ void p0_s5_consts(const Args& a, int g, int part, LAS unsigned char* lds, int tid) {
    const float* a_re = a.in[7]; const float* a_im = a.in[8]; const float* log_dt = a.in[9];
    const float* b_re = a.in[10]; const float* b_im = a.in[11]; const float* c_re = a.in[12]; const float* c_im = a.in[13]; const float* dsk = a.in[14];
    LAS f32x2* PW = (LAS f32x2*)lds;
    LAS f32x2* BB = PW + 17 * 64;
    LAS f32x2* CC = BB + 64 * 16;
    LAS float* DD = (LAS float*)(CC + 1024);
    const int p0 = tid & 63, pb0 = tid >> 4, pb1 = pb0 + 32, hh = tid & 15;
    const float ldt = log_dt[g];
    const float are0 = a_re[g * 64 + p0], aim0 = a_im[g * 64 + p0];
    const float areb[2] = {a_re[g * 64 + pb0], a_re[g * 64 + pb1]}, aimb[2] = {a_im[g * 64 + pb0], a_im[g * 64 + pb1]};
    const float brv[2] = {b_re[(g * 64 + pb0) * 16 + hh], b_re[(g * 64 + pb1) * 16 + hh]}, biv[2] = {b_im[(g * 64 + pb0) * 16 + hh], b_im[(g * 64 + pb1) * 16 + hh]};
    const float crv[2] = {c_re[g * 1024 + tid], c_re[g * 1024 + tid + 512]}, civ[2] = {c_im[g * 1024 + tid], c_im[g * 1024 + tid + 512]};
    const float ddv = tid < 16 ? dsk[g * 16 + tid] : 0.f;
    const float dt = expf(ldt);
#pragma unroll
    for (int k = 0; k < 3; ++k) { const int tau = (tid >> 6) + 8 * k;
        if (tau < 17) { const float th = aim0 * dt, mg = expf((float)tau * (are0 * dt)); float sn, cs; sincos_rev((double)th * (double)tau * INV_2PI, sn, cs);
            PW[tau * 64 + p0] = (f32x2){mg * cs, mg * sn}; } }
#pragma unroll
    for (int k = 0; k < 2; ++k) { const float are = areb[k], aim = aimb[k];
        const float th = aim * dt, mg = expf(are * dt); float sn, cs; sincos_rev((double)th * INV_2PI, sn, cs);
        const float lre = mg * cs, lim = mg * sn, nr = lre - 1.0f, den = are * are + aim * aim;
        const float fre = (nr * are + lim * aim) / den, fim = (lim * are - nr * aim) / den;
        BB[tid + 512 * k] = (f32x2){fre * brv[k] - fim * biv[k], fre * biv[k] + fim * brv[k]};
        CC[tid + 512 * k] = (f32x2){crv[k], civ[k]}; }
    if (tid < 16) DD[tid] = ddv;
    __syncthreads();
    unsigned char* gc = a.ws + WS_S5C + (size_t)g * S5C_GROUP;
    if (part == 0 && tid < 64) ((f32x2*)(a.ws + WS_LBT))[g * 64 + tid] = PW[16 * 64 + tid];
    if (part < 2) for (int pi = part * 512 + tid; pi < part * 512 + 512; pi += NTHR) { const int delta = pi >> 6, ln = pi & 63, fq = ln >> 4, h = ln & 15, lag = delta - (fq >> 1);
        float v[8];
#pragma unroll
        for (int j = 0; j < 8; ++j) v[j] = 0.f;
        if (lag >= 0) {
            for (int p = 0; p < 64; ++p) { const f32x2 cc = CC[h * 64 + p], pw = PW[lag * 64 + p]; const float zr = cc.x * pw.x - cc.y * pw.y, zi = cc.x * pw.y + cc.y * pw.x;
#pragma unroll
                for (int j = 0; j < 8; ++j) { const f32x2 bb = BB[p * 16 + 8 * (fq & 1) + j]; v[j] += zr * bb.x - zi * bb.y; } }
            if (lag == 0) {
#pragma unroll
                for (int j = 0; j < 8; ++j) if (8 * (fq & 1) + j == h) v[j] += DD[h];
            }
        }
        v4u o; o.x = pk2(v[0], v[1]); o.y = pk2(v[2], v[3]); o.z = pk2(v[4], v[5]); o.w = pk2(v[6], v[7]);
        *(v4u*)(gc + (size_t)pi * 16) = o; }
    if (part == 2) for (int e = tid; e < 4096; e += NTHR) { const int ln = e & 63, ks = (e >> 6) & 7, nt = e >> 9, fq = ln >> 4, fr = ln & 15;
        const int n = 16 * nt + fr, p = n >> 1, ri = n & 1, s = 2 * ks + (fq >> 1); const f32x2 pw = PW[(15 - s) * 64 + p];
        float v[8];
#pragma unroll
        for (int j = 0; j < 8; ++j) { const f32x2 bb = BB[p * 16 + 8 * (fq & 1) + j]; v[j] = ri ? (pw.x * bb.y + pw.y * bb.x) : (pw.x * bb.x - pw.y * bb.y); }
        v4u o; o.x = pk2(v[0], v[1]); o.y = pk2(v[2], v[3]); o.z = pk2(v[4], v[5]); o.w = pk2(v[6], v[7]);
        *(v4u*)(gc + S5C_WE + (size_t)e * 16) = o; }
    if (part == 3) for (int e = tid; e < 4096; e += NTHR) { const int ln = e & 63, ks = (e >> 6) & 3, tt = e >> 8, fq = ln >> 4, h = ln & 15;
        float v[8];
#pragma unroll
        for (int jj = 0; jj < 4; ++jj) { const int p = 16 * ks + 4 * fq + jj; const f32x2 cc = CC[h * 64 + p], pw = PW[(tt + 1) * 64 + p];
            v[2 * jj] = cc.x * pw.x - cc.y * pw.y; v[2 * jj + 1] = -(cc.x * pw.y + cc.y * pw.x); }
        v4u o; o.x = pk2(v[0], v[1]); o.y = pk2(v[2], v[3]); o.z = pk2(v[4], v[5]); o.w = pk2(v[6], v[7]);
        *(v4u*)(gc + S5C_WY + (size_t)e * 16) = o; }
    __syncthreads();
}

__device__ __forceinline__ void p0_part_a(const Args& a, LAS unsigned char* lds, int tid, int lane, int wave, int G, int bx) {
    for (int task = bx; task < 256; task += G) p0_s5_consts(a, task >> 2, task & 3, lds, tid);
}
__device__ __forceinline__ void p0_part_b(const Args& a, LAS unsigned char* lds, int tid, int lane, int wave, int G, int bx) {
    { float* rp = (float*)(a.ws + WS_ROPE);
      for (int i = bx * NTHR + tid; i < 4096 * 64; i += G * NTHR) { const int pos = i >> 6, j = i & 63;
          const float invf = exp2f(-(float)j * (13.287712379549449f / 64.0f)); const float ang = (float)pos * invf;
          float s, c; sincos_rev((double)ang * INV_2PI, s, c); rp[i] = c; rp[262144 + i] = s; } }
}
__device__ __forceinline__ void p0_part_c(const Args& a, LAS unsigned char* lds, int tid, int lane, int wave, int G, int bx) {
    { const float* cvec = a.in[1]; const float* w_ada = a.in[2]; float* part = (float*)(a.ws + WS_PART); LAS float* sl = (LAS float*)lds;
      for (int it = bx; it < 6 * 42; it += G) { const int cb = it % 6, kg = it / 6, r0 = kg < 38 ? kg * 48 : 1824 + (kg - 38) * 56, nr = kg < 38 ? 48 : 56;
          __syncthreads();
          if (tid < 4 * 56) { const int b = tid / 56, rr = tid % 56; const float cv = rr < nr ? cvec[b * 2048 + r0 + rr] : 0.f; sl[b * 56 + rr] = cv / (1.0f + expf(-cv)); }
          __syncthreads();
          f32x4 acc[4];
#pragma unroll
          for (int b = 0; b < 4; ++b) acc[b] = (f32x4){0.f, 0.f, 0.f, 0.f};
          const int col = cb * 2048 + tid * 4;
          for (int k0 = 0; k0 < nr; k0 += 8) {
              f32x4 wv[8];
#pragma unroll
              for (int kk = 0; kk < 8; ++kk) wv[kk] = __builtin_nontemporal_load((const f32x4*)(w_ada + (size_t)(r0 + k0 + kk) * 12288 + col));
#pragma unroll
              for (int kk = 0; kk < 8; ++kk)
#pragma unroll
                  for (int b = 0; b < 4; ++b) acc[b] += wv[kk] * sl[b * 56 + k0 + kk]; }
#pragma unroll
          for (int b = 0; b < 4; ++b) *(f32x4*)(part + ((size_t)kg * 4 + b) * 12288 + col) = acc[b];
      }
      __syncthreads(); }
}
__device__ __forceinline__ void p0_part_d(const Args& a, LAS unsigned char* lds, int tid, int lane, int wave, int G, int bx) {
    { LAS float* scr = (LAS float*)(lds + wave * 16384);
      const int gw = bx * NWAVES + wave, NGW = G * NWAVES;
      constexpr int I_IN = (DM / 64) * (INW / 32), I_SQ = (DM / 64) * (DM / 32), I_GLU = (1024 / 64) * (4096 / 32);
      for (int it = gw; it < I_IN + 2 * I_SQ + I_GLU; it += NGW) { int r = it;
          if (r < I_IN) { transpose_item(a.in[5], DM, INW, (bf16*)(a.ws + WS_WIN), PERM_WIN, 0, scr, r, lane); continue; } r -= I_IN;
          if (r < I_SQ) { transpose_item(a.in[6], DM, DM, (bf16*)(a.ws + WS_WRET), PERM_NONE, 0, scr, r, lane); continue; } r -= I_SQ;
          if (r < I_SQ) { transpose_item(a.in[16], DM, DM, (bf16*)(a.ws + WS_WOUT), PERM_NONE, 0, scr, r, lane); continue; } r -= I_SQ;
          transpose_item(a.in[15], 1024, 4096, (bf16*)(a.ws + WS_WGLU), PERM_PAIR, 2048, scr, r, lane); } }
    __syncthreads();
}
__device__ __forceinline__ void p0_prologue(const Args& a, LAS unsigned char* lds, int tid, int lane, int wave, int G) {
    const int bx = blockIdx.x;
    const bool late = (bx & 1) != 0;
    if (!late) p0_part_a(a, lds, tid, lane, wave, G, bx);
    p0_part_b(a, lds, tid, lane, wave, G, bx); p0_part_c(a, lds, tid, lane, wave, G, bx); p0_part_d(a, lds, tid, lane, wave, G, bx);
    if (late) p0_part_a(a, lds, tid, lane, wave, G, bx);
}

__device__ __forceinline__ void p0b_mod_reduce(const Args& a, int gtid, int nthr) {
    const float* part = (const float*)(a.ws + WS_PART); const float* b_ada = a.in[3]; float* mf = (float*)(a.ws + WS_MODF);
    for (int i = gtid; i < 4 * 12288 / 4; i += nthr) { const int b = i / 3072, j4 = (i % 3072) * 4;
        f32x4 acc = *(const f32x4*)(b_ada + j4);
#pragma unroll 14
        for (int kg = 0; kg < 42; ++kg) acc += *(const f32x4*)(part + ((size_t)kg * 4 + b) * 12288 + j4);
        *(f32x4*)(mf + b * 12288 + j4) = acc; }
}
__device__ __forceinline__ f32x4 modf4(const float* modf_, int b, int idx) { return *(const f32x4*)(modf_ + b * 12288 + idx); }
__device__ __forceinline__ void p1_prenorm(const Args& a, int lane, int gw, int NGW) {
    const float* x = a.in[0]; const float* g0 = a.in[4]; const float* mf = (const float*)(a.ws + WS_MODF);
    bf16* H = (bf16*)((unsigned char*)a.out + DO_H);
    for (int rb = gw; rb < MTOK / 8; rb += NGW) { const int row0 = rb * 8, b = row0 >> 12;
        f32x4 ca[8], cb[8];
#pragma unroll
        for (int j = 0; j < 8; ++j) { const int col = 4 * (lane + 64 * j); ca[j] = *(const f32x4*)(g0 + col) * (1.0f + modf4(mf, b, 2048 + col)); cb[j] = modf4(mf, b, col); if (j & 1) asm volatile("" ::: "memory"); }
        f32x4 v[8], nv[8];
        { const f32x4* xr = (const f32x4*)(x + (size_t)row0 * DM) + lane;
#pragma unroll
          for (int j = 0; j < 8; ++j) v[j] = __builtin_nontemporal_load(xr + 64 * j); }
#pragma unroll
        for (int r = 0; r < 8; ++r) { const int row = row0 + r;
            if (r < 7) { const f32x4* xr = (const f32x4*)(x + (size_t)(row + 1) * DM) + lane;
#pragma unroll
                for (int j = 0; j < 8; ++j) nv[j] = __builtin_nontemporal_load(xr + 64 * j); }
            float ss = 0.f;
#pragma unroll
            for (int j = 0; j < 8; ++j) ss += (v[j].x * v[j].x + v[j].y * v[j].y) + (v[j].z * v[j].z + v[j].w * v[j].w);
            const float rstd = rsqrtf(wave_sum(ss) * (1.0f / DM) + 1e-6f);
            v2u* o8 = (v2u*)(H + (size_t)row * DM) + lane;
#pragma unroll
            for (int j = 0; j < 8; ++j) { const f32x4 h = v[j] * rstd * ca[j] + cb[j]; v2u w; w.x = pk2(h.x, h.y); w.y = pk2(h.z, h.w); o8[64 * j] = w; }
#pragma unroll
            for (int j = 0; j < 8; ++j) v[j] = nv[j]; } }
}
__device__ __forceinline__ void p8_mid(const Args& a, int lane, int gw, int NGW) {
    const float* x = a.in[0]; const float* gains = a.in[4]; const float* mod = (const float*)(a.ws + WS_MOD); const float* b_ada = a.in[3];
    const bf16* Y1 = (const bf16*)(a.ws + WS_Y1); bf16* H2 = (bf16*)(a.ws + WS_H2); const float* mf = (const float*)(a.ws + WS_MODF);
    for (int rb = gw; rb < MTOK / 8; rb += NGW) { const int row0 = rb * 8, b = row0 >> 12;
        f32x4 c1[8], ca[8];
#pragma unroll
        for (int j = 0; j < 8; ++j) { const int col = 4 * (lane + 64 * j); c1[j] = *(const f32x4*)(gains + 2048 + col) * modf4(mf, b, 4096 + col);
            ca[j] = *(const f32x4*)(gains + 4096 + col) * (1.0f + modf4(mf, b, 8192 + col)); if (j & 1) asm volatile("" ::: "memory"); }
#pragma unroll 1
        for (int r = 0; r < 8; ++r) { const int row = row0 + r;
            const f32x4* xr = (const f32x4*)(x + (size_t)row * DM) + lane; const v2u* yr = (const v2u*)(Y1 + (size_t)row * DM) + lane;
            f32x4 v[8]; v2u yw[8]; float ssy = 0.f;
#pragma unroll
            for (int j = 0; j < 8; ++j) { v[j] = __builtin_nontemporal_load(xr + 64 * j); yw[j] = __builtin_nontemporal_load(yr + 64 * j); }
#pragma unroll
            for (int j = 0; j < 8; ++j) { const f32x4 y = (f32x4){bflo(yw[j].x), bfhi(yw[j].x), bflo(yw[j].y), bfhi(yw[j].y)}; ssy += (y.x * y.x + y.y * y.y) + (y.z * y.z + y.w * y.w); }
            const float rstdy = rsqrtf(wave_sum(ssy) * (1.0f / DM) + 1e-6f); float ss = 0.f;
            v2u* xo = (v2u*)((bf16*)(a.ws + WS_X1B) + (size_t)row * DM) + lane;
#pragma unroll
            for (int j = 0; j < 8; ++j) { const f32x4 y = (f32x4){bflo(yw[j].x), bfhi(yw[j].x), bflo(yw[j].y), bfhi(yw[j].y)};
                v[j] = v[j] + c1[j] * (y * rstdy); { v2u xw; xw.x = pk2(v[j].x, v[j].y); xw.y = pk2(v[j].z, v[j].w); xo[64 * j] = xw; } ss += (v[j].x * v[j].x + v[j].y * v[j].y) + (v[j].z * v[j].z + v[j].w * v[j].w); }
            f32x4 cbv[8];
#pragma unroll
            for (int j = 0; j < 8; ++j) cbv[j] = modf4(mf, b, 6144 + 4 * (lane + 64 * j));
            const float rstd = rsqrtf(wave_sum(ss) * (1.0f / DM) + 1e-6f);
            v2u* o8 = (v2u*)(H2 + (size_t)row * DM) + lane;
#pragma unroll
            for (int j = 0; j < 8; ++j) { const f32x4 h = v[j] * rstd * ca[j] + cbv[j]; v2u w; w.x = pk2(h.x, h.y); w.y = pk2(h.z, h.w); o8[64 * j] = w; } } }
}
__device__ __forceinline__ void p11_final(const Args& a, int lane, int gw, int NGW) {
    const float* gains = a.in[4]; const float* mod = (const float*)(a.ws + WS_MOD); const float* b_ada = a.in[3];
    const bf16* Y2 = (const bf16*)(a.ws + WS_Y2); const float* mf = (const float*)(a.ws + WS_MODF);
    for (int rb = gw; rb < MTOK / 8; rb += NGW) { const int row0 = rb * 8, b = row0 >> 12;
        f32x4 c3[8];
#pragma unroll
        for (int j = 0; j < 8; ++j) { const int col = 4 * (lane + 64 * j); c3[j] = *(const f32x4*)(gains + 6144 + col) * modf4(mf, b, 10240 + col); }
#pragma unroll 2
        for (int r = 0; r < 8; ++r) { const int row = row0 + r;
            f32x4* xr = (f32x4*)(a.out + (size_t)row * DM) + lane; const v2u* yr = (const v2u*)(Y2 + (size_t)row * DM) + lane;
            const v2u* x1r = (const v2u*)((const bf16*)(a.ws + WS_X1B) + (size_t)row * DM) + lane;
            f32x4 v[8]; v2u yw[8]; float ssy = 0.f;
#pragma unroll
            for (int j = 0; j < 8; ++j) { const v2u xw = __builtin_nontemporal_load(x1r + 64 * j); v[j] = (f32x4){bflo(xw.x), bfhi(xw.x), bflo(xw.y), bfhi(xw.y)}; yw[j] = __builtin_nontemporal_load(yr + 64 * j); }
#pragma unroll
            for (int j = 0; j < 8; ++j) { const f32x4 y = (f32x4){bflo(yw[j].x), bfhi(yw[j].x), bflo(yw[j].y), bfhi(yw[j].y)}; ssy += (y.x * y.x + y.y * y.y) + (y.z * y.z + y.w * y.w); }
            const float rstdy = rsqrtf(wave_sum(ssy) * (1.0f / DM) + 1e-6f);
#pragma unroll
            for (int j = 0; j < 8; ++j) { const f32x4 y = (f32x4){bflo(yw[j].x), bfhi(yw[j].x), bflo(yw[j].y), bfhi(yw[j].y)}; xr[64 * j] = v[j] + c3[j] * (y * rstdy); } } }
}

constexpr int RA_KP = 288, RA_VP = 544, RA_K = 0, RA_V = 128 * RA_KP;
constexpr int RC_P = 272, RC_VP = 288, RC_Q = 0, RC_K = 128 * RC_P, RC_V = 2 * 128 * RC_P, RC_T = RC_V + 128 * RC_VP;
__device__ __forceinline__ void retA_phase(const bf16* PROJ, bf16* XT, LAS unsigned char* lds, int tid, int lane, int w, int bx, int G) {
    const int fq = lane >> 4, fr = lane & 15;
    const int loK = (8 * fq + (fr >> 2)) * RA_KP + 8 * (lane & 3), loV = (8 * fq + (fr >> 2)) * RA_VP + 8 * (lane & 3);
    v4u rk[4], rv[8];
    v2u pend[16]; bf16* pxo = nullptr;
    int uid = bx;
    if (uid < 1024) { const int b = uid >> 8, h = (uid >> 5) & 7, n = uid & 31, tok0 = b * SEQL + n * 128;
#pragma unroll
        for (int i = 0; i < 4; ++i) { const int id = tid + NTHR * i; rk[i] = __builtin_nontemporal_load((const v4u*)(PROJ + (size_t)(tok0 + (id >> 4)) * PJW + K_OFF + h * 128 + (id & 15) * 8)); }
#pragma unroll
        for (int i = 0; i < 8; ++i) { const int id = tid + NTHR * i; rv[i] = __builtin_nontemporal_load((const v4u*)(PROJ + (size_t)(tok0 + (id >> 5)) * PJW + V_OFF + h * 256 + (id & 31) * 8)); } }
    for (; uid < 1024; uid += G) {
#pragma unroll
        for (int i = 0; i < 4; ++i) { const int id = tid + NTHR * i; *(LAS v4u*)(lds + RA_K + (id >> 4) * RA_KP + (id & 15) * 16) = rk[i]; }
#pragma unroll
        for (int i = 0; i < 8; ++i) { const int id = tid + NTHR * i; *(LAS v4u*)(lds + RA_V + (id >> 5) * RA_VP + (id & 31) * 16) = rv[i]; }
        __syncthreads();
        if (pxo) {
#pragma unroll
            for (int nt = 0; nt < 16; ++nt) *(v2u*)(pxo + (16 * nt + fr) * 128 + 16 * w + 4 * fq) = pend[nt]; }
        const int nuid = uid + G;
        if (nuid < 1024) { const int b = nuid >> 8, h = (nuid >> 5) & 7, n = nuid & 31, tok0 = b * SEQL + n * 128;
#pragma unroll
            for (int i = 0; i < 4; ++i) { const int id = tid + NTHR * i; rk[i] = __builtin_nontemporal_load((const v4u*)(PROJ + (size_t)(tok0 + (id >> 4)) * PJW + K_OFF + h * 128 + (id & 15) * 8)); }
#pragma unroll
            for (int i = 0; i < 8; ++i) { const int id = tid + NTHR * i; rv[i] = __builtin_nontemporal_load((const v4u*)(PROJ + (size_t)(tok0 + (id >> 5)) * PJW + V_OFF + h * 256 + (id & 31) * 8)); } }
        bf16x8 af[4];
#pragma unroll
        for (int ks = 0; ks < 4; ++ks) af[ks] = tr_frag(lds + RA_K, RA_KP, 32 * ks, 16 * w, loK);
        bf16* xo = XT + (size_t)uid * 32768;
#pragma unroll
        for (int nt = 0; nt < 16; ++nt) { f32x4 acc = (f32x4){0.f, 0.f, 0.f, 0.f}; bf16x8 bfr[4];
#pragma unroll
            for (int ks = 0; ks < 4; ++ks) bfr[ks] = tr_frag(lds + RA_V, RA_VP, 32 * ks, 16 * nt, loV);
            __builtin_amdgcn_sched_barrier(0);
#pragma unroll
            for (int ks = 0; ks < 4; ++ks) acc = MFMA16(af[ks], bfr[ks], acc);
            __builtin_amdgcn_sched_barrier(0);
            v2u o; o.x = pk2(acc[0], acc[1]); o.y = pk2(acc[2], acc[3]);
            pend[nt] = o; }
        pxo = xo;
        __syncthreads();
    }
    if (pxo) {
#pragma unroll
        for (int nt = 0; nt < 16; ++nt) *(v2u*)(pxo + (16 * nt + fr) * 128 + 16 * w + 4 * fq) = pend[nt]; }
}
__device__ __forceinline__ void retB_scan(const bf16* XT, bf16* TT, int first, int stride) {
    for (int e = first; e < 32 * 4096; e += stride) { const int bh = e >> 12, off = (e & 4095) * 8; const int h = bh & 7;
        const float cd = exp2f(128.0f * pg8::lg2_gamma(h));
        float t[8];
#pragma unroll
        for (int j = 0; j < 8; ++j) t[j] = 0.f;
        const bf16* xp = XT + (size_t)bh * 32 * 32768 + off; bf16* tp = TT + (size_t)bh * 32 * 32768 + off;
#pragma unroll 1
        for (int n0 = 0; n0 < 32; n0 += 16) {
        v4u xv[16];
#pragma unroll
        for (int n = 0; n < 16; ++n) xv[n] = __builtin_nontemporal_load((const v4u*)(xp + (size_t)(n0 + n) * 32768));
#pragma unroll
        for (int n = 0; n < 16; ++n) {
            v4u o; o.x = pk2(t[0], t[1]); o.y = pk2(t[2], t[3]); o.z = pk2(t[4], t[5]); o.w = pk2(t[6], t[7]);
            *(v4u*)(tp + (size_t)(n0 + n) * 32768) = o;
            t[0] = cd * t[0] + bflo(xv[n].x); t[1] = cd * t[1] + bfhi(xv[n].x); t[2] = cd * t[2] + bflo(xv[n].y); t[3] = cd * t[3] + bfhi(xv[n].y);
            t[4] = cd * t[4] + bflo(xv[n].z); t[5] = cd * t[5] + bfhi(xv[n].z); t[6] = cd * t[6] + bflo(xv[n].w); t[7] = cd * t[7] + bfhi(xv[n].w); } } }
}
__device__ __forceinline__ void retC_phase(const bf16* PROJ, const bf16* TT, bf16* A2, LAS unsigned char* lds, int tid, int lane, int w, int bx, int G) {
    const int fq = lane >> 4, fr = lane & 15, srow = tid >> 4, sch = tid & 15;
    const int loV = (8 * fq + (fr >> 2)) * RC_VP + 8 * (lane & 3);
    LAS unsigned char* si = lds + RC_K + w * (16 * RC_P);
    v4u rq[4], rk[4], rv[4], rt[4];
    v2u pend[16]; bf16* pop = nullptr;
    int uid = bx;
    if (uid < 1024) { const int b = uid >> 8, h = (uid >> 5) & 7, n = uid & 31, tok0 = b * SEQL + n * 128;
#pragma unroll
        for (int i = 0; i < 4; ++i) { const int row = srow + 32 * i; const bf16* pr = PROJ + (size_t)(tok0 + row) * PJW + sch * 8;
            rq[i] = __builtin_nontemporal_load((const v4u*)(pr + Q_OFF + h * 128)); rk[i] = __builtin_nontemporal_load((const v4u*)(pr + K_OFF + h * 128)); rv[i] = __builtin_nontemporal_load((const v4u*)(pr + V_OFF + h * 256));
            rt[i] = __builtin_nontemporal_load((const v4u*)(TT + (size_t)uid * 32768 + row * 128 + sch * 8)); } }
    for (; uid < 1024; uid += G) {
        const int b = uid >> 8, h = (uid >> 5) & 7, n = uid & 31, tok0 = b * SEQL + n * 128;
#pragma unroll
        for (int i = 0; i < 4; ++i) { const int row = srow + 32 * i;
            *(LAS v4u*)(lds + RC_Q + row * RC_P + sch * 16) = rq[i]; *(LAS v4u*)(lds + RC_K + row * RC_P + sch * 16) = rk[i];
            *(LAS v4u*)(lds + RC_V + row * RC_VP + sch * 16) = rv[i]; *(LAS v4u*)(lds + RC_T + row * RC_P + sch * 16) = rt[i]; }
        __syncthreads();
        if (pop) {
#pragma unroll
            for (int t = 0; t < 16; ++t) *(v2u*)(pop + 16 * t) = pend[t]; }
#pragma unroll
        for (int i = 0; i < 4; ++i) { const int row = srow + 32 * i;
            rv[i] = __builtin_nontemporal_load((const v4u*)(PROJ + (size_t)(tok0 + row) * PJW + V_OFF + h * 256 + 128 + sch * 8));
            rt[i] = __builtin_nontemporal_load((const v4u*)(TT + (size_t)uid * 32768 + (128 + row) * 128 + sch * 8)); }
        bf16x8 qf[4];
#pragma unroll
        for (int ks = 0; ks < 4; ++ks) qf[ks] = *(const LAS bf16x8*)(lds + RC_Q + (16 * w + fr) * RC_P + (32 * ks + 8 * fq) * 2);
        v2u sp[8];
#pragma unroll
        for (int st = 0; st < 8; ++st) { sp[st] = (v2u){0u, 0u};
            if (st <= w) { f32x4 sa = (f32x4){0.f, 0.f, 0.f, 0.f}; bf16x8 kfr[4];
#pragma unroll
                for (int ks = 0; ks < 4; ++ks) kfr[ks] = *(const LAS bf16x8*)(lds + RC_K + (16 * st + fr) * RC_P + (32 * ks + 8 * fq) * 2);
                __builtin_amdgcn_sched_barrier(0);
#pragma unroll
                for (int ks = 0; ks < 4; ++ks) sa = MFMA16(kfr[ks], qf[ks], sa);
                __builtin_amdgcn_sched_barrier(0);
                const int c = 16 * w + fr, s0 = 16 * st + 4 * fq;
#pragma unroll
                for (int i = 0; i < 4; ++i) if (s0 + i > c) sa[i] = 0.f;
                sp[st].x = pk2(sa[0], sa[1]); sp[st].y = pk2(sa[2], sa[3]); } }
        __syncthreads();
#pragma unroll
        for (int st = 0; st < 8; ++st) *(LAS v2u*)(si + fr * RC_P + (16 * st + 4 * fq) * 2) = sp[st];
        bf16x8 sf[4];
#pragma unroll
        for (int ks = 0; ks < 4; ++ks) sf[ks] = *(const LAS bf16x8*)(si + fr * RC_P + (32 * ks + 8 * fq) * 2);
        const float cd = exp2f(128.0f * pg8::lg2_gamma(h));
        f32x4 o[16];
#define RC_HALF(vh, SB) _Pragma("unroll") for (int vt = 0; vt < 8; ++vt) { f32x4 acc = (f32x4){0.f, 0.f, 0.f, 0.f}; bf16x8 tfr[4], vfr[4]; \
            _Pragma("unroll") for (int ks = 0; ks < 4; ++ks) { tfr[ks] = *(const LAS bf16x8*)(lds + RC_T + (16 * vt + fr) * RC_P + (32 * ks + 8 * fq) * 2); vfr[ks] = tr_frag(lds + RC_V, RC_VP, 32 * ks, 16 * vt, loV); } \
            if (SB) __builtin_amdgcn_sched_barrier(0); \
            f32x4 accv = (f32x4){0.f, 0.f, 0.f, 0.f}; \
            _Pragma("unroll") for (int ks = 0; ks < 4; ++ks) { acc = MFMA16(tfr[ks], qf[ks], acc); accv = MFMA16(vfr[ks], sf[ks], accv); } \
            acc = acc * cd + accv; \
            if (SB) __builtin_amdgcn_sched_barrier(0); \
            o[(vh) * 8 + vt] = acc; }
        RC_HALF(0, true)
        __syncthreads();
#pragma unroll
        for (int i = 0; i < 4; ++i) { const int row = srow + 32 * i;
            *(LAS v4u*)(lds + RC_V + row * RC_VP + sch * 16) = rv[i]; *(LAS v4u*)(lds + RC_T + row * RC_P + sch * 16) = rt[i]; }
        __syncthreads();
        const int nuid = uid + G;
        if (nuid < 1024) { const int b2 = nuid >> 8, h2 = (nuid >> 5) & 7, n2 = nuid & 31, tk2 = b2 * SEQL + n2 * 128;
#pragma unroll
            for (int i = 0; i < 4; ++i) { const int row = srow + 32 * i; const bf16* pr = PROJ + (size_t)(tk2 + row) * PJW + sch * 8;
                rq[i] = __builtin_nontemporal_load((const v4u*)(pr + Q_OFF + h2 * 128)); rk[i] = __builtin_nontemporal_load((const v4u*)(pr + K_OFF + h2 * 128)); rv[i] = __builtin_nontemporal_load((const v4u*)(pr + V_OFF + h2 * 256));
                rt[i] = __builtin_nontemporal_load((const v4u*)(TT + (size_t)nuid * 32768 + row * 128 + sch * 8)); } }
        const int tok = tok0 + 16 * w + fr;
        const bf16* gp = PROJ + (size_t)tok * PJW + G_OFF + h * 256 + 4 * fq; bf16* op = A2 + (size_t)tok * DM + h * 256 + 4 * fq;
        RC_HALF(1, true)
        v2u rg[16];
#pragma unroll
        for (int t = 0; t < 16; ++t) rg[t] = __builtin_nontemporal_load((const v2u*)(gp + 16 * t));
#undef RC_HALF
        float s1 = 0.f;
#pragma unroll
        for (int t = 0; t < 16; ++t) s1 += (o[t][0] + o[t][1]) + (o[t][2] + o[t][3]);
        s1 += __shfl_xor(s1, 16); s1 += __shfl_xor(s1, 32);
        const float mu = s1 * (1.0f / 256.0f); float s2 = 0.f;
#pragma unroll
        for (int t = 0; t < 16; ++t) { const f32x4 d = o[t] - mu; s2 += (d[0] * d[0] + d[1] * d[1]) + (d[2] * d[2] + d[3] * d[3]); }
        s2 += __shfl_xor(s2, 16); s2 += __shfl_xor(s2, 32);
        const float rstd = rsqrtf(s2 * (1.0f / 256.0f) + 1e-5f);
#pragma unroll
        for (int t = 0; t < 16; ++t) { const v2u g = rg[t]; const f32x4 d = (o[t] - mu) * rstd;
            v2u wv; wv.x = pk2(d[0] * bflo(g.x), d[1] * bfhi(g.x)); wv.y = pk2(d[2] * bflo(g.y), d[3] * bfhi(g.y)); pend[t] = wv; }
        pop = op;
        __syncthreads();
    }
    if (pop) {
#pragma unroll
        for (int t = 0; t < 16; ++t) *(v2u*)(pop + 16 * t) = pend[t]; }
}

__device__ __forceinline__ void s5_load_u(const bf16* US, int t, int g, int lane, bf16x8 (&uf)[8]) {
    const int fq = lane >> 4, fr = lane & 15;
    const bf16* up = US + ((size_t)g * MTOK + 256 * t + 16 * fr + (fq >> 1)) * 16 + 8 * (fq & 1);
#pragma unroll
    for (int ks = 0; ks < 8; ++ks) uf[ks] = __builtin_nontemporal_load((const bf16x8*)(up + 32 * ks));
}
__device__ __forceinline__ void s5_local_state(const Args& a, int t, int g, int lane, LAS unsigned char* we) {
    const bf16* PROJ = (const bf16*)(a.ws + WS_PROJ); float* E = (float*)(a.ws + WS_E);
    const int fq = lane >> 4, fr = lane & 15, b = t >> 4;
    bf16x8 uf[8]; s5_load_u((const bf16*)(a.ws + WS_US), t, g, lane, uf);
    float* ep = E + ((size_t)(b * 256 + (t & 15) * 16 + fr) * 64 + g) * 128 + 4 * fq;
#pragma unroll
    for (int nt = 0; nt < 8; ++nt) { f32x4 acc = (f32x4){0.f, 0.f, 0.f, 0.f}; bf16x8 wfr[8];
#pragma unroll
        for (int ks = 0; ks < 8; ++ks) wfr[ks] = *(const LAS bf16x8*)(we + ((nt * 8 + ks) * 64 + lane) * 16);
        __builtin_amdgcn_sched_barrier(0);
        f32x4 acc2 = (f32x4){0.f, 0.f, 0.f, 0.f};
#pragma unroll
        for (int ks = 0; ks < 8; ++ks) { if (ks & 1) acc2 = MFMA16(wfr[ks], uf[ks], acc2); else acc = MFMA16(wfr[ks], uf[ks], acc); }
        acc = acc + acc2;
        __builtin_amdgcn_sched_barrier(0);
        *(f32x4*)(ep + 16 * nt) = acc; }
}
__device__ __forceinline__ void s5_carry_scan(const Args& a, int pair, int lane, int w, LAS unsigned char* lds) {
    const int b = pair >> 6, g = pair & 63;
    const f32x2 lb = ((const f32x2*)(a.ws + WS_LBT))[g * 64 + lane];
    const float* ep = (const float*)(a.ws + WS_E) + ((size_t)(b * 256 + 32 * w) * 64 + g) * 128 + 2 * lane;
    bf16* xp = (bf16*)(a.ws + WS_XS) + ((size_t)(b * 256 + 32 * w) * 64 + g) * 128 + 2 * lane;
    LAS f32x2* seg = (LAS f32x2*)lds;
    f32x2 e[32];
#pragma unroll
    for (int i = 0; i < 32; ++i) e[i] = __builtin_nontemporal_load((const f32x2*)(ep + (size_t)i * 8192));
    float sr = 0.f, si = 0.f;
#pragma unroll
    for (int i = 0; i < 32; ++i) { const float nr = lb.x * sr - lb.y * si + e[i].x, ni = lb.x * si + lb.y * sr + e[i].y; sr = nr; si = ni; }
    __syncthreads();
    seg[w * 64 + lane] = (f32x2){sr, si};
    f32x2 l32 = lb;
#pragma unroll
    for (int q = 0; q < 5; ++q) l32 = (f32x2){l32.x * l32.x - l32.y * l32.y, 2.0f * l32.x * l32.y};
    __syncthreads();
    float xr = 0.f, xi = 0.f;
    for (int j = 0; j < w; ++j) { const f32x2 sj = seg[j * 64 + lane]; const float nr = l32.x * xr - l32.y * xi + sj.x, ni = l32.x * xi + l32.y * xr + sj.y; xr = nr; xi = ni; }
#pragma unroll
    for (int i = 0; i < 32; ++i) { *(unsigned*)(xp + (size_t)i * 8192) = pk2(xr, xi);
        const float nr = lb.x * xr - lb.y * xi + e[i].x, ni = lb.x * xi + lb.y * xr + e[i].y; xr = nr; xi = ni; }
}
__device__ __forceinline__ float gelu_tanh(float x) {
    const float z = 0.7978845608028654f * (x + 0.044715f * x * x * x);
    const float e = __expf(2.0f * z);
    return 0.5f * x * (2.0f - 2.0f * __builtin_amdgcn_rcpf(e + 1.0f));
}
__device__ __forceinline__ void s5_output(const Args& a, int t, int g, int lane, LAS unsigned char* gc) {
    const bf16* PROJ = (const bf16*)(a.ws + WS_PROJ); const bf16* XS = (const bf16*)(a.ws + WS_XS); bf16* YS = (bf16*)(a.ws + WS_YS);
    const int fq = lane >> 4, fr = lane & 15, b = t >> 4;
    bf16x8 uf[8]; s5_load_u((const bf16*)(a.ws + WS_US), t, g, lane, uf);
    bf16x8 xf[4];
    const bf16* xsp = XS + ((size_t)(b * 256 + (t & 15) * 16 + fr) * 64 + g) * 128 + 8 * fq;
#pragma unroll
    for (int ks = 0; ks < 4; ++ks) xf[ks] = __builtin_nontemporal_load((const bf16x8*)(xsp + 32 * ks));
    bf16* yp = YS + (size_t)(256 * t + 16 * fr) * 1024 + 16 * g + 4 * fq;
#pragma unroll
    for (int tt = 0; tt < 16; ++tt) { f32x4 acc = (f32x4){0.f, 0.f, 0.f, 0.f}; bf16x8 tfr[8], wfr[4];
#pragma unroll
        for (int ks = 0; ks <= tt / 2; ++ks) tfr[ks] = *(const LAS bf16x8*)(gc + ((tt - 2 * ks) * 64 + lane) * 16);
#pragma unroll
        for (int ks = 0; ks < 4; ++ks) wfr[ks] = *(const LAS bf16x8*)(gc + (int)S5C_WY + ((tt * 4 + ks) * 64 + lane) * 16);
        __builtin_amdgcn_sched_barrier(0);
        f32x4 acc2 = (f32x4){0.f, 0.f, 0.f, 0.f};
#pragma unroll
        for (int ks = 0; ks <= tt / 2; ++ks) { if (ks & 1) acc2 = MFMA16(tfr[ks], uf[ks], acc2); else acc = MFMA16(tfr[ks], uf[ks], acc); }
#pragma unroll
        for (int ks = 0; ks < 4; ++ks) { if (ks & 1) acc = MFMA16(wfr[ks], xf[ks], acc); else acc2 = MFMA16(wfr[ks], xf[ks], acc2); }
        acc = acc + acc2;
        __builtin_amdgcn_sched_barrier(0);
        v2u o; o.x = pk2(gelu_tanh(acc[0]), gelu_tanh(acc[1])); o.y = pk2(gelu_tanh(acc[2]), gelu_tanh(acc[3]));
        *(v2u*)(yp + (size_t)tt * 1024) = o; }
}

#define RLX_AGENT __ATOMIC_RELAXED, __HIP_MEMORY_SCOPE_AGENT
#define XB_TMO      128
#define XB_XCNT(j)  (256  + 64 * (j))
#define XB_XSUB(j)  (1280 + 64 * (j))
#define XB_XGEN(j)  (2304 + 64 * (j))
#define XB_TOP      3328
#define XB_TOPGEN   3392
#define XCD_BAR_WORDS 3456
#define XB_SPIN_CAP (1u << 18)

__device__ __forceinline__ unsigned xb_ld(unsigned* p)              { return __hip_atomic_load(p, __ATOMIC_RELAXED, __HIP_MEMORY_SCOPE_AGENT); }
__device__ __forceinline__ unsigned xb_add(unsigned* p, unsigned v) { return __hip_atomic_fetch_add(p, v, __ATOMIC_RELAXED, __HIP_MEMORY_SCOPE_AGENT); }
__device__ __forceinline__ unsigned xb_xcc_id() { return (unsigned)__builtin_amdgcn_s_getreg((3 << 11) | 20) & 0xFu; }
#define XB_SPIN(cond, bar) do { unsigned _sp = 0; while (cond) { __builtin_amdgcn_s_sleep(1); \
    if ((++_sp & 255u) == 0u) { if (xb_ld(&(bar)[XB_TMO])) break; if (_sp > XB_SPIN_CAP) { atomicAdd(&(bar)[XB_TMO], 1u); break; } } } } while (0)

struct XcdBarrier {
    unsigned* bar; unsigned x;
    volatile LAS unsigned* st;
};

__device__ __forceinline__ XcdBarrier xcd_barrier_post(unsigned* bar, volatile LAS unsigned* st) {
    XcdBarrier b; b.bar = bar; b.x = xb_xcc_id(); b.st = st;
    if (threadIdx.x == 0) (void)xb_add(&bar[XB_XCNT(b.x)], 1u);
    return b;
}
__device__ __forceinline__ void xcd_barrier_complete(unsigned* bar, unsigned x, unsigned& nloc, unsigned& nx) {
    const unsigned G = gridDim.x * gridDim.y * gridDim.z;
    unsigned sum, cnt, mine, sp = 0u;
    for (;;) {
        sum = 0u; cnt = 0u; mine = 0u;
#pragma unroll
        for (unsigned j = 0; j < 16; ++j) { const unsigned c = xb_ld(&bar[XB_XCNT(j)]); sum += c; cnt += (c > 0u) ? 1u : 0u; mine = (j == x) ? c : mine; }
        if (sum == G) break;
        __builtin_amdgcn_s_sleep(1);
        if ((++sp & 255u) == 0u) { if (xb_ld(&bar[XB_TMO])) break; if (sp > XB_SPIN_CAP) { atomicAdd(&bar[XB_TMO], 1u); break; } }
    }
    nloc = mine > 0u ? mine : 1u; nx = cnt > 0u ? cnt : 1u;
}

__device__ __forceinline__ void xcd_barrier(const XcdBarrier& b) {
    asm volatile("s_waitcnt vmcnt(0)" ::: "memory");
    __syncthreads();
    if (threadIdx.x == 0) {
        unsigned* bar = b.bar;
        __builtin_amdgcn_s_waitcnt(0);
        unsigned nloc = b.st[0], nx = b.st[1];
        if (nloc == 0u) { xcd_barrier_complete(bar, b.x, nloc, nx); b.st[0] = nloc; b.st[1] = nx; }
        const unsigned old = xb_add(&bar[XB_XSUB(b.x)], 1u);
        const unsigned gen = old / nloc;
        if (old + 1u == (gen + 1u) * nloc) {
            __builtin_amdgcn_fence(__ATOMIC_RELEASE, "agent");
            asm volatile("s_waitcnt vmcnt(0)" ::: "memory");
            const unsigned og = xb_add(&bar[XB_TOP], 1u);
            const unsigned tg = og / nx;
            if (og + 1u == (tg + 1u) * nx) xb_add(&bar[XB_TOPGEN], 1u);
            else XB_SPIN(xb_ld(&bar[XB_TOPGEN]) == tg, bar);
            __builtin_amdgcn_fence(__ATOMIC_ACQUIRE, "agent");
            xb_add(&bar[XB_XGEN(b.x)], 1u);
            asm volatile("s_waitcnt vmcnt(0)" ::: "memory");
        } else {
            XB_SPIN(xb_ld(&bar[XB_XGEN(b.x)]) == gen, bar);
            __builtin_amdgcn_fence(__ATOMIC_ACQUIRE, "agent");
            asm volatile("s_waitcnt vmcnt(0)" ::: "memory");
        }
    }
    __syncthreads();
}

struct PairOrder {
    pg8::StaticOrder base;
    __device__ __forceinline__ bool next(int i, pg8::Unit& u) const { pg8::Unit r; if (!base.next(i >> 1, r)) return false; u.pm = r.pm; u.pn = 2 * r.pn + (i & 1); return true; }
    __device__ __forceinline__ void a_ready(const pg8::Unit&) const {}
    __device__ __forceinline__ void done(const pg8::Unit&) const {}
};
__global__ void __launch_bounds__(NTHR, 2) fwd_megakernel(Args a) {
    extern __shared__ __attribute__((aligned(16))) unsigned char lds_raw[];
    LAS unsigned char* lds = (LAS unsigned char*)lds_raw;
    const int tid = threadIdx.x, lane = tid & 63, wave = __builtin_amdgcn_readfirstlane(tid >> 6);
    const int G = gridDim.x, bx = blockIdx.x;
    const int gw = bx * NWAVES + wave, NGW = G * NWAVES;
    const int lo = a.ph_lo, hi = a.ph_hi;
    cg::grid_group grid = cg::this_grid();
    if (tid < 16) ((LAS unsigned*)(lds + LDS_BAR_OFF))[tid] = 0u;
    __syncthreads();
    XcdBarrier xbar; xbar.bar = (unsigned*)(a.ws + WS_BAR); xbar.x = 0; xbar.st = (volatile LAS unsigned*)(lds + LDS_BAR_OFF);
    if (hi - lo > 1) xbar = xcd_barrier_post((unsigned*)(a.ws + WS_BAR), (volatile LAS unsigned*)(lds + LDS_BAR_OFF));
#define IN(k) (lo <= (k) && (k) < hi)
#ifndef MK_DUP
#define MK_DUP 0
#endif
#define REP(k) for (int rep_ = 0; rep_ < (((MK_DUP) >> (k)) & 1) + 1; ++rep_)
#define SEAM(k) do { if ((k) + 1 < hi) { if ((k) == 0) grid.sync(); else xcd_barrier(xbar); } } while (0)
    bf16* PROJ = (bf16*)(a.ws + WS_PROJ);
    unsigned char* dob = (unsigned char*)a.out;

    if (IN(0)) { p0_prologue(a, lds, tid, lane, wave, G); SEAM(0); }
    if (IN(1)) { p0b_mod_reduce(a, bx * NTHR + tid, G * NTHR); SEAM(1); }
#ifndef MK_XSYNC
#define MK_XSYNC 0
#endif
    if (IN(2)) for (int xs_ = 0; xs_ < MK_XSYNC; ++xs_) grid.sync();
    if (IN(2)) REP(2) { p1_prenorm(a, lane, gw, NGW); SEAM(2); }
    if (IN(3)) REP(3) {
        pg8::Gemm g{(const bf16*)(dob + DO_H), (const bf16*)(a.ws + WS_WIN), MTOK, INW, DM}; pg8::StaticOrder S; S.init(MTOK, INW, G, bx);
        pg8::EpiProj E{PROJ, (const float*)(a.ws + WS_ROPE), (bf16*)(a.ws + WS_US)};
        pg8::gemm_phase<pg8::EpiProj, pg8::StaticOrder, true, true>(lds, g, S, E);
        SEAM(3);
    }
    if (IN(4)) REP(4) {
        REP(16) retA_phase(PROJ, (bf16*)(dob + DO_XT), lds, tid, lane, wave, bx, G);
        REP(17) { int gl = -1;
          for (int bu = bx; bu < 512; bu += G) { const int g = ((bu & 7) << 3) | ((bu >> 3) & 7);
              if (g != gl) { __syncthreads(); const unsigned char* src = a.ws + WS_S5C + (size_t)g * S5C_GROUP + S5C_WE;
                  { v4u stg[8];
#pragma unroll
                    for (int i = 0; i < 8; ++i) stg[i] = *(const v4u*)(src + (size_t)(tid + NTHR * i) * 16);
#pragma unroll
                    for (int i = 0; i < 8; ++i) *(LAS v4u*)(lds + (tid + NTHR * i) * 16) = stg[i]; }
                  __syncthreads(); gl = g; }
              s5_local_state(a, (bu >> 6) * 8 + wave, g, lane, lds); }
          __syncthreads(); }
        SEAM(4);
    }
    if (IN(5)) REP(5) {
        for (int pair = bx; pair < 256; pair += G) s5_carry_scan(a, pair, lane, wave, lds);
        retB_scan((const bf16*)(dob + DO_XT), (bf16*)(dob + DO_TT), bx * NTHR + tid, G * NTHR);
        __syncthreads();
        SEAM(5);
    }
    if (IN(6)) REP(6) {
        REP(18) retC_phase(PROJ, (const bf16*)(dob + DO_TT), (bf16*)(dob + DO_A2), lds, tid, lane, wave, bx, G);
        REP(19) { int gl = -1;
          for (int bu = bx; bu < 512; bu += G) { const int g = ((bu & 7) << 3) | ((bu >> 3) & 7);
              if (g != gl) { __syncthreads(); const unsigned char* src = a.ws + WS_S5C + (size_t)g * S5C_GROUP;
                  { v4u stg[10];
#pragma unroll
                    for (int i = 0; i < 10; ++i) stg[i] = *(const v4u*)(src + (size_t)(tid + NTHR * i) * 16);
#pragma unroll
                    for (int i = 0; i < 10; ++i) *(LAS v4u*)(lds + (tid + NTHR * i) * 16) = stg[i]; }
                  __syncthreads(); gl = g; }
              s5_output(a, (bu >> 6) * 8 + wave, g, lane, lds); }
          __syncthreads(); }
        SEAM(6);
    }
    if (IN(7)) REP(7) {
        pg8::StaticOrder SR; SR.init(MTOK, DM, G, bx);
        { pg8::Gemm g{(const bf16*)(a.ws + WS_YS), (const bf16*)(a.ws + WS_WGLU), MTOK, 4096, 1024}; PairOrder S{SR};
          pg8::EpiPair<true> E{(bf16*)(dob + DO_MS), DM, PROJ, GS_OFF};
          pg8::gemm_phase<pg8::EpiPair<true>, PairOrder, true, true>(lds, g, S, E); }
        asm volatile("s_waitcnt vmcnt(0)" ::: "memory"); __syncthreads();
        { pg8::Gemm g{(const bf16*)(dob + DO_A2), (const bf16*)(a.ws + WS_WRET), MTOK, DM, DM};
          pg8::EpiMerge E{(bf16*)(a.ws + WS_MERGED), PROJ, (const bf16*)(dob + DO_MS)};
          pg8::gemm_phase<pg8::EpiMerge, pg8::StaticOrder, true, true>(lds, g, SR, E); }
        SEAM(7);
    }
    if (IN(9)) REP(9) {
        pg8::Gemm g{(const bf16*)(a.ws + WS_MERGED), (const bf16*)(a.ws + WS_WOUT), MTOK, DM, DM}; pg8::StaticOrder S; S.init(MTOK, DM, G, bx);
        pg8::EpiPlain E{(bf16*)(a.ws + WS_Y1), DM};
        pg8::gemm_phase<pg8::EpiPlain, pg8::StaticOrder, true, true>(lds, g, S, E);
        SEAM(9);
    }
    if (IN(10)) REP(10) {
        p8_mid(a, lane, gw, NGW);
        LAS float* scr = (LAS float*)(lds + wave * 16384);
        constexpr int I_FIN = (DM / 64) * (INW / 32), I_FOUT = (DFF / 64) * (DM / 32);
        for (int it = gw; it < I_FIN + I_FOUT; it += NGW) {
            if (it < I_FIN) transpose_item(a.in[17], DM, INW, (bf16*)(a.ws + WS_WFIN), PERM_PAIR, DFF, scr, it, lane);
            else transpose_item(a.in[18], DFF, DM, (bf16*)(a.ws + WS_WFOUT), PERM_NONE, 0, scr, it - I_FIN, lane); }
        __syncthreads();
        SEAM(10);
    }
    if (IN(11)) REP(11) {
        pg8::Gemm g{(const bf16*)(a.ws + WS_H2), (const bf16*)(a.ws + WS_WFIN), MTOK, INW, DM}; pg8::StaticOrder S; S.init(MTOK, INW, G, bx);
        pg8::EpiPair<false> E{(bf16*)(a.ws + WS_ACT), DFF, nullptr, 0};
        pg8::gemm_phase<pg8::EpiPair<false>, pg8::StaticOrder, true, true>(lds, g, S, E);
        SEAM(11);
    }
    if (IN(12)) REP(12) {
        pg8::Gemm g{(const bf16*)(a.ws + WS_ACT), (const bf16*)(a.ws + WS_WFOUT), MTOK, DM, DFF}; pg8::StaticOrder S; S.init(MTOK, DM, G, bx);
        pg8::EpiPlain E{(bf16*)(a.ws + WS_Y2), DM};
        pg8::gemm_phase<pg8::EpiPlain, pg8::StaticOrder, true, true>(lds, g, S, E);
        SEAM(12);
    }
    if (IN(13)) { p11_final(a, lane, gw, NGW); }
#undef IN
#undef SEAM
}

extern "C" void kernel_launch(void* const* d_in, const int* in_sizes, int n_in, void* d_out, int out_size, void* d_ws, size_t ws_size, hipStream_t stream) {
    static int grid = 0;
    if (grid == 0) {
        if (n_in != 19 || out_size != MTOK * DM || ws_size < WS_END) { fprintf(stderr, "kernel_launch: unexpected problem (n_in %d out %d ws %zu)\n", n_in, out_size, ws_size); grid = -1; return; }
        int dev = 0, cus = 0, per_cu = 0;
        (void)hipGetDevice(&dev); (void)hipDeviceGetAttribute(&cus, hipDeviceAttributeMultiprocessorCount, dev);
        if (hipFuncSetAttribute((const void*)fwd_megakernel, hipFuncAttributeMaxDynamicSharedMemorySize, LDS_BYTES) != hipSuccess) { fprintf(stderr, "kernel_launch: hipFuncSetAttribute failed\n"); grid = -1; return; }
        if (hipOccupancyMaxActiveBlocksPerMultiprocessor(&per_cu, (const void*)fwd_megakernel, NTHR, LDS_BYTES) != hipSuccess || per_cu < 1) { fprintf(stderr, "kernel_launch: occupancy query failed (%d)\n", per_cu); (void)hipGetLastError(); per_cu = 1; }
        if (per_cu > 1) per_cu = 1;
        grid = cus * per_cu;
    }
    if (grid < 0) return;
    (void)hipMemsetAsync((unsigned char*)d_ws + WS_MOD, 0, CTL_ZERO_BYTES, stream);
    Args a{};
    for (int i = 0; i < 19; ++i) a.in[i] = (const float*)d_in[i];
    a.out = (float*)d_out; a.ws = (unsigned char*)d_ws;
#if MK_PER_PHASE
    for (int p = 0; p <= N_PHASES; ++p) { a.ph_lo = p; a.ph_hi = p + 1; hipLaunchKernelGGL(fwd_megakernel, dim3(grid), dim3(NTHR), LDS_BYTES, stream, a); }
#else
    a.ph_lo = 0; a.ph_hi = N_PHASES + 1;
    void* args[] = {&a};
    hipError_t e = hipLaunchCooperativeKernel((const void*)fwd_megakernel, dim3(grid), dim3(NTHR), args, LDS_BYTES, stream);
    if (e != hipSuccess) fprintf(stderr, "kernel_launch: cooperative launch failed: %s (grid %d)\n", hipGetErrorString(e), grid);
#endif
}
```
